# Optimizing an MI355X kernel written in HIP

```python
import jax, jax.numpy as jnp
from jax import lax
import numpy as np

D_MODEL = 1024
BATCH = 4
SEQ = 4096
DEPTH = 1

CHUNK = 64
Q_BLOCK = 128
SB_HEADS = 8
SB_HEAD_DIM = 64
SB_WIDTH = SB_HEADS * SB_HEAD_DIM
HG_HEADS = 4
HG_HEAD_DIM = 128
HG_WIDTH = HG_HEADS * HG_HEAD_DIM
N_BRANCH = 2
D_FF = 4 * D_MODEL
IN_COLS = 3 * SB_WIDTH + 4 * HG_WIDTH + N_BRANCH * D_MODEL
EPS = 1e-6

kernel_name = "hybrid_stickbreak_hgrn2_gated_merge"


def rmsnorm(x, g):
    xf = x.astype(jnp.float32)
    y = xf * lax.rsqrt(jnp.mean(xf * xf, axis=-1, keepdims=True) + EPS)
    return y * g.astype(jnp.float32)


def split_heads(t, n_heads):
    b, s, w = t.shape
    return t.reshape(b, s, n_heads, w // n_heads).transpose(0, 2, 1, 3)


def merge_heads(t):
    b, h, s, d = t.shape
    return t.transpose(0, 2, 1, 3).reshape(b, s, h * d)


def stick_breaking_attention(q, k, v):
    b, h, s, dh = q.shape
    nb = s // Q_BLOCK
    scale = dh ** -0.5
    qb = q.reshape(b, h, nb, Q_BLOCK, dh).transpose(2, 0, 1, 3, 4)
    kpos = jnp.arange(s)

    def block(args):
        qi, i = args
        qpos = i * Q_BLOCK + jnp.arange(Q_BLOCK)
        z = jnp.einsum('bhqd,bhkd->bhqk', qi, k) * scale
        mask = kpos[None, :] < qpos[:, None]
        log_beta = jax.nn.log_sigmoid(z)
        log_rem = jnp.where(mask, log_beta - z, 0.0)
        between = lax.cumsum(log_rem, axis=3, reverse=True) - log_rem
        w = jnp.where(mask, jnp.exp(log_beta + between), 0.0)
        return jnp.einsum('bhqk,bhkd->bhqd', w, v)

    out = lax.map(block, (qb, jnp.arange(nb)))
    return out.transpose(1, 2, 0, 3, 4).reshape(b, h, s, dh)


def hgrn2_chunkwise(q, k, v, log_f):
    b, h, s, dk = q.shape
    dv = v.shape[-1]
    nc = s // CHUNK

    def to_chunks(t):
        return t.reshape(b, h, nc, CHUNK, t.shape[-1]).transpose(2, 0, 1, 3, 4)

    qc, kc, vc, gc = to_chunks(q), to_chunks(k), to_chunks(v), to_chunks(log_f)
    causal = jnp.arange(CHUNK)[:, None] >= jnp.arange(CHUNK)[None, :]

    def step(state, inp):
        qi, ki, vi, gi = inp
        bcum = jnp.cumsum(gi, axis=2)
        diff = bcum[:, :, :, None, :] - bcum[:, :, None, :, :]
        decay = jnp.exp(jnp.where(causal[:, :, None], diff, -jnp.inf))
        scores = jnp.einsum('bhtd,bhsd,bhtsd->bhts', qi, ki, decay)
        o = jnp.einsum('bhts,bhse->bhte', scores, vi) \
            + jnp.einsum('bhtd,bhde->bhte', qi * jnp.exp(bcum), state)
        b_last = bcum[:, :, -1:, :]
        k_dec = ki * jnp.exp(b_last - bcum)
        state = jnp.exp(b_last[:, :, 0, :])[..., None] * state \
            + jnp.einsum('bhsd,bhse->bhde', k_dec, vi)
        return state, o

    s0 = jnp.zeros((b, h, dk, dv), jnp.float32)
    _, o = lax.scan(step, s0, (qc, kc, vc, gc))
    return o.transpose(1, 2, 0, 3, 4).reshape(b, h, s, dv)


def hybrid_layer(x, layer, norm1_g, w_in, b_gate, lb_logits, hg_norm_g, w_o_sb, w_o_hg, w_out,
                 norm2_g, w_ff1, w_ff2):
    f32 = jnp.float32
    xn = rmsnorm(x, norm1_g[layer])
    u = xn @ w_in[layer].astype(f32)
    c = np.cumsum([SB_WIDTH, SB_WIDTH, SB_WIDTH, HG_WIDTH, HG_WIDTH, HG_WIDTH, HG_WIDTH, D_MODEL])
    q_sb, k_sb, v_sb, f_raw, i_hg, q_hg, g_hg, gate_sb, gate_hg = jnp.split(u, list(c), axis=-1)

    o_sb = stick_breaking_attention(split_heads(q_sb, SB_HEADS), split_heads(k_sb, SB_HEADS),
                                    split_heads(v_sb, SB_HEADS))
    o_sb = merge_heads(o_sb)

    lb_all = jnp.cumsum(jax.nn.softmax(lb_logits.astype(f32), axis=0), axis=0)
    lb = lb_all[layer]
    sig = jax.nn.sigmoid(f_raw)
    f = lb + (1.0 - lb) * sig
    log_f = jnp.log(f)
    k_hg = (1.0 - lb) * jax.nn.sigmoid(-f_raw)
    o_hg = hgrn2_chunkwise(split_heads(jax.nn.silu(q_hg), HG_HEADS), split_heads(k_hg, HG_HEADS),
                           split_heads(i_hg, HG_HEADS), split_heads(log_f, HG_HEADS))
    o_hg = rmsnorm(o_hg, hg_norm_g[layer].reshape(HG_HEADS, 1, HG_HEAD_DIM))
    o_hg = merge_heads(o_hg) * jax.nn.silu(g_hg)

    bg = b_gate[layer].astype(f32)
    g_a = jax.nn.sigmoid(gate_sb + bg[:D_MODEL])
    g_b = jax.nn.sigmoid(gate_hg + bg[D_MODEL:])
    merged = g_a * (o_sb @ w_o_sb[layer].astype(f32)) + g_b * (o_hg @ w_o_hg[layer].astype(f32))
    h = x.astype(f32) + merged @ w_out[layer].astype(f32)

    hn = rmsnorm(h, norm2_g[layer])
    a = jnp.square(jax.nn.relu(hn @ w_ff1[layer].astype(f32)))
    h = h + a @ w_ff2[layer].astype(f32)
    return h


def setup_inputs(seed: int = 0) -> dict:
    key = jax.random.key(seed)
    ks = jax.random.split(key, 14)
    f32 = jnp.float32

    def nrm(k, shape, fan_in):
        return jax.random.normal(k, shape, f32) * (fan_in ** -0.5)

    return {
        "x": jax.random.normal(ks[0], (BATCH, SEQ, D_MODEL), f32),
        "norm1_g": 1.0 + 0.05 * jax.random.normal(ks[1], (DEPTH, D_MODEL), f32),
        "w_in": nrm(ks[2], (DEPTH, D_MODEL, IN_COLS), D_MODEL),
        "b_gate": 0.05 * jax.random.normal(ks[3], (DEPTH, N_BRANCH * D_MODEL), f32),
        "lb_logits": 0.5 * jax.random.normal(ks[4], (DEPTH + 1, HG_WIDTH), f32),
        "hg_norm_g": 1.0 + 0.05 * jax.random.normal(ks[5], (DEPTH, HG_WIDTH), f32),
        "w_o_sb": nrm(ks[6], (DEPTH, SB_WIDTH, D_MODEL), SB_WIDTH),
        "w_o_hg": nrm(ks[7], (DEPTH, HG_WIDTH, D_MODEL), HG_WIDTH),
        "w_out": nrm(ks[8], (DEPTH, D_MODEL, D_MODEL), D_MODEL),
        "norm2_g": 1.0 + 0.05 * jax.random.normal(ks[9], (DEPTH, D_MODEL), f32),
        "w_ff1": nrm(ks[10], (DEPTH, D_MODEL, D_FF), D_MODEL),
        "w_ff2": nrm(ks[11], (DEPTH, D_FF, D_MODEL), D_FF),
        "final_g": 1.0 + 0.05 * jax.random.normal(ks[12], (D_MODEL,), f32),
    }


def reference(x, norm1_g, w_in, b_gate, lb_logits, hg_norm_g, w_o_sb, w_o_hg, w_out,
              norm2_g, w_ff1, w_ff2, final_g):
    h = x.astype(jnp.float32)
    for layer in range(DEPTH):
        h = hybrid_layer(h, layer, norm1_g, w_in, b_gate, lb_logits, hg_norm_g, w_o_sb, w_o_hg,
                         w_out, norm2_g, w_ff1, w_ff2)
    return rmsnorm(h, final_g).astype(x.dtype)
```

```cpp
#include <hip/hip_runtime.h>
#include <hip/hip_cooperative_groups.h>
#include <cstdio>
#include <cstdint>
#include <cmath>
namespace cg = cooperative_groups;
namespace pg8 {
#define PG8_LAS __attribute__((address_space(3)))
typedef unsigned short bf16_t;
typedef short bf16x8 __attribute__((ext_vector_type(8)));
typedef float f32x4 __attribute__((ext_vector_type(4)));
typedef unsigned u32x4 __attribute__((ext_vector_type(4)));
constexpr int BM = 256, BK = 64, HALF = 128, HTB = HALF * BK * 2  , STAGE_BYTES = 8 * HTB, NXCD = 8, WGM = 8;

__host__ __device__ __forceinline__ int lds_byte(int r, int c) { const int st = (r >> 4) * 2 + (c >> 5), rr = r & 15, cc = c & 31, ob = rr * 64 + cc * 2; return st * 1024 + (ob ^ (((ob >> 9) & 1) << 5)); }
__host__ __device__ __forceinline__ void stage_rc(int b, int& R, int& C) { const int st = b / 1024, sb = b % 1024, swz = sb ^ (((sb >> 9) & 1) << 5); R = (st >> 1) * 16 + swz / 64; C = (st & 1) * 32 + (swz % 64) / 2; }
__host__ __device__ __forceinline__ int perm32(int rho) { const int n = rho >> 4, i = rho & 15; return 8 * (i >> 2) + 4 * n + (i & 3); }

struct Unit { int pm, pn; };
struct Gemm { const bf16_t* A; const bf16_t* Bt; int M, N, K; };

struct StaticOrder {
    int nM, nN, nwg, G, c;
    __host__ __device__ void init(int M, int N, int G_, int c_) { nM = M / BM; nN = N / BM; nwg = nM * nN; G = G_; c = c_; }
    __host__ __device__ bool next(int i, Unit& u) const {
        const long L = (long)i * G + c; if (L >= nwg) return false;
        int wgid = (int)L; { const int q = nwg / NXCD, r = nwg % NXCD, xcd = wgid % NXCD, off = wgid / NXCD; wgid = (xcd < r ? xcd * (q + 1) : r * (q + 1) + (xcd - r) * q) + off; }
        const int nig = WGM * nN, gid = wgid / nig, fm = gid * WGM, gsz = (nM - fm) < WGM ? (nM - fm) : WGM;
        u.pm = fm + ((wgid % nig) % gsz); u.pn = (wgid % nig) / gsz; return true;
    }
    __device__ __forceinline__ void a_ready(const Unit&) const {}
    __device__ __forceinline__ void done(const Unit&) const {}
};

__device__ __forceinline__ unsigned cvt_pk_bf16(float lo, float hi) { unsigned r; asm volatile("v_cvt_pk_bf16_f32 %0, %1, %2" : "=v"(r) : "v"(lo), "v"(hi)); return r; }
typedef float f32x2 __attribute__((ext_vector_type(2)));
template <class Epi, class Sched, bool ALIGN_EPI = false, bool SP2 = false>
__device__ __forceinline__ void gemm_phase(PG8_LAS unsigned char* lds, const Gemm g, const Sched& S, const Epi& E) {
    const int tid = threadIdx.x, wid = __builtin_amdgcn_readfirstlane(tid >> 6), lane = tid & 63, wr = wid >> 2, wc = wid & 3, fr = lane & 15, fq = lane >> 4;
    const int K = g.K, nt = K / BK;
    unsigned voffA[2], voffB[2];
#pragma unroll
    for (int i = 0; i < 2; ++i) { int R, C; stage_rc(tid * 16 + i * 8192, R, C); const int Rb = Epi::PERM ? ((R & ~31) + perm32(R & 31)) : R;
        voffA[i] = (unsigned)(R * K + C) * 2u; voffB[i] = (unsigned)(Rb * K + C) * 2u; }
    const size_t kstep = (size_t)(BK * 2);
    const size_t hstep = (size_t)HALF * K * 2;
    const size_t tstep = 2 * hstep;
    const unsigned ldsw = (unsigned)wid * 1024u;
    const int aoff = lds_byte(wr * 64 + fr, fq * 8), boff = lds_byte(wc * 32 + fr, fq * 8);
#define PG8_SA(b, h) (((b) * 2 + (h)) * HTB)
#define PG8_SB(b, h) ((4 + (b) * 2 + (h)) * HTB)
#define PG8_STAGE(bufoff, gbase, voff) do { _Pragma("unroll") for (int _i = 0; _i < 2; ++_i) \
        __builtin_amdgcn_global_load_lds((const unsigned*)((const char*)(gbase) + (voff)[_i]), (PG8_LAS unsigned*)(lds + (bufoff) + ldsw + _i * 8192), 16, 0, 0); } while (0)
#define PG8_LDA(dst, b, h) do { _Pragma("unroll") for (int m = 0; m < 4; ++m) _Pragma("unroll") for (int k = 0; k < 2; ++k) dst[m][k] = *(const PG8_LAS bf16x8*)(lds + PG8_SA(b, h) + aoff + m * 2048 + k * 1024); } while (0)
#define PG8_LDB(dst, b, h) do { _Pragma("unroll") for (int n = 0; n < 2; ++n) _Pragma("unroll") for (int k = 0; k < 2; ++k) dst[n][k] = *(const PG8_LAS bf16x8*)(lds + PG8_SB(b, h) + boff + n * 2048 + k * 1024); } while (0)
#define PG8_MMA(ai, bj, At, Bt) do { __builtin_amdgcn_s_setprio(1); _Pragma("unroll") for (int m = 0; m < 4; ++m) _Pragma("unroll") for (int n = 0; n < 2; ++n) _Pragma("unroll") for (int k = 0; k < 2; ++k) \
        acc[ai][bj][m][n] = __builtin_amdgcn_mfma_f32_16x16x32_bf16(Bt[n][k], At[m][k], acc[ai][bj][m][n], 0, 0, 0); __builtin_amdgcn_s_setprio(0); } while (0)
#define PG8_WAIT_V(n) asm volatile("s_waitcnt vmcnt(" #n ")" ::: "memory")
#define PG8_WAIT_L(n) asm volatile("s_waitcnt lgkmcnt(" #n ")" ::: "memory")
#define PG8_BAR __builtin_amdgcn_s_barrier()
#define PG8_SCHED __builtin_amdgcn_sched_barrier(0)
    Unit cur, nxt; int ui = 0;
    if (!S.next(0, cur)) return;
    f32x4 acc[2][2][4][2];
#pragma unroll
    for (int a = 0; a < 2; ++a)
#pragma unroll
        for (int b = 0; b < 2; ++b)
#pragma unroll
            for (int m = 0; m < 4; ++m)
#pragma unroll
                for (int n = 0; n < 2; ++n) acc[a][b][m][n] = (f32x4){0.f, 0.f, 0.f, 0.f};
    bf16x8 At[4][2], B0[2][2], B1[2][2];
    const char* cA = (const char*)g.A + (size_t)cur.pm * tstep; const char* cB = (const char*)g.Bt + (size_t)cur.pn * tstep;
    S.a_ready(cur);
    if constexpr (SP2) {
        PG8_STAGE(PG8_SB(0, 0), cB, voffB); PG8_STAGE(PG8_SB(0, 1), cB + hstep, voffB); PG8_STAGE(PG8_SA(0, 0), cA, voffA); PG8_STAGE(PG8_SA(0, 1), cA + hstep, voffA);
        if (wr == 1) PG8_BAR;
        PG8_WAIT_V(2); PG8_BAR;
        PG8_STAGE(PG8_SB(1, 0), cB + kstep, voffB); PG8_STAGE(PG8_SA(1, 0), cA + kstep, voffA); PG8_STAGE(PG8_SB(1, 1), cB + hstep + kstep, voffB);
        PG8_WAIT_V(6); PG8_BAR;
    } else {
        PG8_STAGE(PG8_SB(0, 0), cB, voffB); PG8_STAGE(PG8_SA(0, 0), cA, voffA); PG8_STAGE(PG8_SB(0, 1), cB + hstep, voffB); PG8_STAGE(PG8_SA(0, 1), cA + hstep, voffA);
        if (wr == 1) PG8_BAR;
        PG8_WAIT_V(4); PG8_BAR;
        PG8_STAGE(PG8_SB(1, 0), cB + kstep, voffB); PG8_STAGE(PG8_SA(1, 0), cA + kstep, voffA); PG8_STAGE(PG8_SB(1, 1), cB + hstep + kstep, voffB);
        PG8_WAIT_V(6); PG8_BAR;
    }
    for (;;) {
        const bool has_next = S.next(ui + 1, nxt);
        const char* nA = has_next ? (const char*)g.A + (size_t)nxt.pm * tstep : cA; const char* nB = has_next ? (const char*)g.Bt + (size_t)nxt.pn * tstep : cB;
        for (int t = 0; t < nt; t += 2) {
            const bool last = (t == nt - 2);
            const char* a1 = cA + (size_t)(t + 1) * kstep;
            const char* a2 = last ? nA : cA + (size_t)(t + 2) * kstep; const char* b2 = last ? nB : cB + (size_t)(t + 2) * kstep;
            const char* a3 = a2 + kstep; const char* b3 = b2 + kstep;
            if (last && has_next) S.a_ready(nxt);
            if constexpr (SP2) {
            PG8_LDB(B0, 0, 0); PG8_LDB(B1, 0, 1); PG8_SCHED; PG8_LDA(At, 0, 0); PG8_STAGE(PG8_SA(1, 1), a1 + hstep, voffA);
            PG8_WAIT_V(8); PG8_WAIT_L(0); PG8_BAR; PG8_MMA(0, 0, At, B0); PG8_MMA(0, 1, At, B1); PG8_BAR; PG8_SCHED;
            PG8_LDA(At, 0, 1); PG8_STAGE(PG8_SB(0, 0), b2, voffB); PG8_STAGE(PG8_SB(0, 1), b2 + hstep, voffB); PG8_STAGE(PG8_SA(0, 0), a2, voffA);
            PG8_WAIT_V(8); PG8_WAIT_L(0); PG8_BAR; PG8_MMA(1, 0, At, B0); PG8_MMA(1, 1, At, B1); PG8_BAR; PG8_SCHED;
            PG8_LDB(B0, 1, 0); PG8_LDB(B1, 1, 1); PG8_SCHED; PG8_LDA(At, 1, 0); PG8_STAGE(PG8_SA(0, 1), a2 + hstep, voffA);
            PG8_WAIT_V(8); PG8_WAIT_L(0); PG8_BAR; PG8_MMA(0, 0, At, B0); PG8_MMA(0, 1, At, B1); PG8_BAR; PG8_SCHED;
            PG8_LDA(At, 1, 1); PG8_STAGE(PG8_SB(1, 0), b3, voffB); PG8_STAGE(PG8_SB(1, 1), b3 + hstep, voffB); PG8_STAGE(PG8_SA(1, 0), a3, voffA);
            PG8_WAIT_V(8); PG8_WAIT_L(0); PG8_BAR; PG8_MMA(1, 0, At, B0); PG8_MMA(1, 1, At, B1); PG8_BAR; PG8_SCHED;
            } else {
            PG8_LDB(B0, 0, 0); PG8_SCHED; PG8_LDA(At, 0, 0); PG8_STAGE(PG8_SA(1, 1), a1 + hstep, voffA);
            PG8_WAIT_L(8); PG8_BAR; PG8_WAIT_L(0); PG8_MMA(0, 0, At, B0); PG8_BAR; PG8_SCHED;
            PG8_LDB(B1, 0, 1); PG8_STAGE(PG8_SB(0, 0), b2, voffB);
            PG8_BAR; PG8_WAIT_L(0); PG8_MMA(0, 1, At, B1); PG8_BAR;
            PG8_LDA(At, 0, 1); PG8_STAGE(PG8_SA(0, 0), a2, voffA);
            PG8_BAR; PG8_WAIT_L(0); PG8_MMA(1, 0, At, B0); PG8_BAR; PG8_SCHED;
            PG8_STAGE(PG8_SB(0, 1), b2 + hstep, voffB);
            PG8_WAIT_V(6); PG8_BAR; PG8_MMA(1, 1, At, B1); PG8_BAR;
            PG8_LDB(B0, 1, 0); PG8_SCHED; PG8_LDA(At, 1, 0); PG8_STAGE(PG8_SA(0, 1), a2 + hstep, voffA);
            PG8_WAIT_L(8); PG8_BAR; PG8_WAIT_L(0); PG8_MMA(0, 0, At, B0); PG8_BAR; PG8_SCHED;
            PG8_LDB(B1, 1, 1); PG8_STAGE(PG8_SB(1, 0), b3, voffB);
            PG8_BAR; PG8_WAIT_L(0); PG8_MMA(0, 1, At, B1); PG8_BAR;
            PG8_LDA(At, 1, 1); PG8_STAGE(PG8_SA(1, 0), a3, voffA);
            PG8_BAR; PG8_WAIT_L(0); PG8_MMA(1, 0, At, B0); PG8_BAR; PG8_SCHED;
            PG8_STAGE(PG8_SB(1, 1), b3 + hstep, voffB);
            PG8_WAIT_V(6); PG8_BAR; PG8_MMA(1, 1, At, B1); PG8_BAR;
            }
        }
        if constexpr (ALIGN_EPI) { if (wr == 0) PG8_BAR; }
        if constexpr (!Epi::AFTER_DRAIN) { E(acc, cur, wr, wc, fr, fq); S.done(cur); }
        if (!has_next) break;
#pragma unroll
        for (int a = 0; a < 2; ++a)
#pragma unroll
            for (int b = 0; b < 2; ++b)
#pragma unroll
                for (int m = 0; m < 4; ++m)
#pragma unroll
                    for (int n = 0; n < 2; ++n) acc[a][b][m][n] = (f32x4){0.f, 0.f, 0.f, 0.f};
        cur = nxt; cA = nA; cB = nB; ++ui;
        if constexpr (ALIGN_EPI) { if (wr == 1) PG8_BAR; }
    }
    PG8_WAIT_V(0);
    if constexpr (!ALIGN_EPI) { if (wr == 0) PG8_BAR; }
    PG8_BAR;
    if constexpr (Epi::AFTER_DRAIN) { E.fused(acc, cur, wr, wc, fr, fq, lds, wid, lane); S.done(cur); }
#undef PG8_SA
#undef PG8_SB
#undef PG8_STAGE
#undef PG8_LDA
#undef PG8_LDB
#undef PG8_MMA
#undef PG8_WAIT_V
#undef PG8_WAIT_L
#undef PG8_BAR
#undef PG8_SCHED
}
}

constexpr int BATCH = 4, SEQ = 4096, DM = 1024, M = BATCH * SEQ, NIN = 5632, FF = 4096, SBW = 512, HGW = 512;
constexpr float EPS = 1e-6f;
constexpr float QSCALE = 0.125f * 1.4426950408889634f;
#define LAS __attribute__((address_space(3)))
typedef unsigned short bf16_t;
typedef short bf16x8 __attribute__((ext_vector_type(8)));
typedef short s16x4 __attribute__((ext_vector_type(4)));
typedef float f32x4 __attribute__((ext_vector_type(4)));
typedef float f32x16 __attribute__((ext_vector_type(16)));
typedef unsigned u32x4 __attribute__((ext_vector_type(4)));
typedef unsigned u32x2 __attribute__((ext_vector_type(2)));
typedef float f32x2_t __attribute__((ext_vector_type(2)));
typedef __bf16 bf16x2_t __attribute__((ext_vector_type(2)));
__device__ __forceinline__ unsigned cvtpk(float lo, float hi) { f32x2_t v = {lo, hi}; bf16x2_t b = __builtin_convertvector(v, bf16x2_t); return __builtin_bit_cast(unsigned, b); }
__device__ __forceinline__ bf16_t cvt1(float x) { return (bf16_t)(cvtpk(x, 0.f) & 0xffffu); }
__device__ __forceinline__ float bf2f(bf16_t b) { return __uint_as_float(((unsigned)b) << 16); }
__device__ __forceinline__ float fexp(float x) { return __builtin_amdgcn_exp2f(x * 1.4426950408889634f); }
__device__ __forceinline__ float fsigmoid(float x) { return __builtin_amdgcn_rcpf(1.0f + __builtin_amdgcn_exp2f(-x * 1.4426950408889634f)); }
__device__ __forceinline__ int crow(int r, int hi) { return (r & 3) + 8 * (r >> 2) + 4 * hi; }
__device__ __forceinline__ bf16x8 pack8(const f32x16& x, int s) {
    u32x4 p; p.x = cvtpk(x[8 * s + 0], x[8 * s + 1]); p.y = cvtpk(x[8 * s + 2], x[8 * s + 3]); p.z = cvtpk(x[8 * s + 4], x[8 * s + 5]); p.w = cvtpk(x[8 * s + 6], x[8 * s + 7]);
    return __builtin_bit_cast(bf16x8, p);
}
#define MFMA32(a, b, c) __builtin_amdgcn_mfma_f32_32x32x16_bf16((a), (b), (c), 0, 0, 0)
typedef short v4i16_t __attribute__((ext_vector_type(4)));
__device__ __forceinline__ bf16x8 trfrag(const LAS unsigned char* p) {
    const s16x4 lo = __builtin_bit_cast(s16x4, __builtin_amdgcn_ds_read_tr16_b64_v4i16((LAS v4i16_t*)p));
    const s16x4 hi = __builtin_bit_cast(s16x4, __builtin_amdgcn_ds_read_tr16_b64_v4i16((LAS v4i16_t*)(p + 512)));
    return (bf16x8){lo[0], lo[1], lo[2], lo[3], hi[0], hi[1], hi[2], hi[3]};
}

namespace pg8 {
struct EpiIn {
    static constexpr bool PERM = true, AFTER_DRAIN = false;
    bf16_t *Q, *K, *V, *I, *QS, *SG, *GA, *GB; float* LF; const float* lbl; const float* bg;
    template <int MODE> __device__ __forceinline__ void body(const f32x4 (&acc)[2][2][4][2], bf16_t* dst, int ldc, int row0, int col0, const float (&aux)[2][8]) const {
#pragma unroll
        for (int ai = 0; ai < 2; ++ai)
#pragma unroll
            for (int m = 0; m < 4; ++m) { const size_t row = (size_t)(row0 + ai * HALF + m * 16);
#pragma unroll
                for (int bj = 0; bj < 2; ++bj) { float v[8];
#pragma unroll
                    for (int j = 0; j < 4; ++j) { v[j] = acc[ai][bj][m][0][j]; v[4 + j] = acc[ai][bj][m][1][j]; }
#pragma unroll
                    for (int j = 0; j < 8; ++j) {
                        if (MODE == 0) v[j] *= QSCALE;
                        if (MODE == 2) { const float sg = fsigmoid(v[j]); const float f = aux[bj][j] + (1.0f - aux[bj][j]) * sg; v[j] = __logf(f); }
                        if (MODE == 3) v[j] = v[j] * fsigmoid(v[j]);
                        if (MODE == 4) v[j] = fsigmoid(v[j] + aux[bj][j]);
                    }
                    if (MODE == 2) { float* p = LF + row * 512 + col0 + bj * HALF; *(f32x4*)p = (f32x4){v[0], v[1], v[2], v[3]}; *(f32x4*)(p + 4) = (f32x4){v[4], v[5], v[6], v[7]}; }
                    else { u32x4 w; w.x = cvtpk(v[0], v[1]); w.y = cvtpk(v[2], v[3]); w.z = cvtpk(v[4], v[5]); w.w = cvtpk(v[6], v[7]); *(u32x4*)(dst + row * ldc + col0 + bj * HALF) = w; }
                } }
    }
    __device__ __forceinline__ void operator()(const f32x4 (&acc)[2][2][4][2], const Unit& u, int wr, int wc, int fr, int fq) const {
        const int pn = u.pn; const int row0 = u.pm * BM + wr * 64 + fr; const int cw = wc * 32 + 8 * fq;
        float aux[2][8];
#pragma unroll
        for (int bj = 0; bj < 2; ++bj)
#pragma unroll
            for (int j = 0; j < 8; ++j) aux[bj][j] = 0.f;
        if (pn < 2) body<0>(acc, Q, 512, row0, pn * 256 + cw, aux);
        else if (pn < 4) body<1>(acc, K, 512, row0, (pn - 2) * 256 + cw, aux);
        else if (pn < 6) body<1>(acc, V, 512, row0, (pn - 4) * 256 + cw, aux);
        else if (pn < 8) { const int c0 = (pn - 6) * 256 + cw;
#pragma unroll
            for (int bj = 0; bj < 2; ++bj)
#pragma unroll
                for (int j = 0; j < 8; ++j) { const int c = c0 + bj * HALF + j; aux[bj][j] = __builtin_amdgcn_rcpf(1.0f + fexp(lbl[512 + c] - lbl[c])); }
            body<2>(acc, nullptr, 512, row0, c0, aux); }
        else if (pn < 10) body<1>(acc, I, 512, row0, (pn - 8) * 256 + cw, aux);
        else if (pn < 12) body<3>(acc, QS, 512, row0, (pn - 10) * 256 + cw, aux);
        else if (pn < 14) body<3>(acc, SG, 512, row0, (pn - 12) * 256 + cw, aux);
        else { const bool second = pn >= 18; const int c0 = (pn - (second ? 18 : 14)) * 256 + cw;
#pragma unroll
            for (int bj = 0; bj < 2; ++bj)
#pragma unroll
                for (int j = 0; j < 8; ++j) aux[bj][j] = bg[(second ? 1024 : 0) + c0 + bj * HALF + j];
            body<4>(acc, second ? GB : GA, 1024, row0, c0, aux); }
    }
};
struct EpiM1 {
    static constexpr bool PERM = true, AFTER_DRAIN = false;
    const bf16_t* GA; float* TMP;
    __device__ __forceinline__ void operator()(const f32x4 (&acc)[2][2][4][2], const Unit& u, int wr, int wc, int fr, int fq) const {
        const int row0 = u.pm * BM + wr * 64 + fr, col0 = u.pn * BM + wc * 32 + 8 * fq;
#pragma unroll
        for (int ai = 0; ai < 2; ++ai)
#pragma unroll
            for (int m = 0; m < 4; ++m) { const size_t off = (size_t)(row0 + ai * HALF + m * 16) * 1024 + col0;
#pragma unroll
                for (int bj = 0; bj < 2; ++bj) { const u32x4 g = *(const u32x4*)(GA + off + bj * HALF); const f32x4 a0 = acc[ai][bj][m][0], a1 = acc[ai][bj][m][1];
                    f32x4 o0, o1; o0.x = a0.x * __uint_as_float(g.x << 16); o0.y = a0.y * __uint_as_float(g.x & 0xffff0000u); o0.z = a0.z * __uint_as_float(g.y << 16); o0.w = a0.w * __uint_as_float(g.y & 0xffff0000u);
                    o1.x = a1.x * __uint_as_float(g.z << 16); o1.y = a1.y * __uint_as_float(g.z & 0xffff0000u); o1.z = a1.z * __uint_as_float(g.w << 16); o1.w = a1.w * __uint_as_float(g.w & 0xffff0000u);
                    float* p = TMP + off + bj * HALF; *(f32x4*)p = o0; *(f32x4*)(p + 4) = o1; } }
    }
};
struct EpiM2 {
    static constexpr bool PERM = true, AFTER_DRAIN = false;
    const bf16_t* GB; const float* TMP; bf16_t* MG;
    __device__ __forceinline__ void operator()(const f32x4 (&acc)[2][2][4][2], const Unit& u, int wr, int wc, int fr, int fq) const {
        const int row0 = u.pm * BM + wr * 64 + fr, col0 = u.pn * BM + wc * 32 + 8 * fq;
#pragma unroll
        for (int ai = 0; ai < 2; ++ai)
#pragma unroll
            for (int m = 0; m < 4; ++m) { const size_t off = (size_t)(row0 + ai * HALF + m * 16) * 1024 + col0;
#pragma unroll
                for (int bj = 0; bj < 2; ++bj) { const u32x4 g = *(const u32x4*)(GB + off + bj * HALF); const f32x4 a0 = acc[ai][bj][m][0], a1 = acc[ai][bj][m][1];
                    const float* p = TMP + off + bj * HALF; const f32x4 t0 = *(const f32x4*)p, t1 = *(const f32x4*)(p + 4);
                    f32x4 o0, o1; o0.x = t0.x + a0.x * __uint_as_float(g.x << 16); o0.y = t0.y + a0.y * __uint_as_float(g.x & 0xffff0000u); o0.z = t0.z + a0.z * __uint_as_float(g.y << 16); o0.w = t0.w + a0.w * __uint_as_float(g.y & 0xffff0000u);
                    o1.x = t1.x + a1.x * __uint_as_float(g.z << 16); o1.y = t1.y + a1.y * __uint_as_float(g.z & 0xffff0000u); o1.z = t1.z + a1.z * __uint_as_float(g.w << 16); o1.w = t1.w + a1.w * __uint_as_float(g.w & 0xffff0000u);
                    u32x4 w; w.x = cvtpk(o0.x, o0.y); w.y = cvtpk(o0.z, o0.w); w.z = cvtpk(o1.x, o1.y); w.w = cvtpk(o1.z, o1.w); *(u32x4*)(MG + off + bj * HALF) = w; } }
    }
};
struct EpiRes {
    static constexpr bool PERM = true, AFTER_DRAIN = false;
    const float* BASE; float* OUT; bf16_t* HB; float* SS;
    __device__ __forceinline__ void operator()(const f32x4 (&acc)[2][2][4][2], const Unit& u, int wr, int wc, int fr, int fq) const {
        const int row0 = u.pm * BM + wr * 64 + fr, col0 = u.pn * BM + wc * 32 + 8 * fq;
#pragma unroll
        for (int ai = 0; ai < 2; ++ai)
#pragma unroll
            for (int m = 0; m < 4; ++m) { const int row = row0 + ai * HALF + m * 16; const size_t off = (size_t)row * 1024 + col0; float ss = 0.f;
#pragma unroll
                for (int bj = 0; bj < 2; ++bj) { const float* bp = BASE + off + bj * HALF; const f32x4 o0 = *(const f32x4*)bp + acc[ai][bj][m][0], o1 = *(const f32x4*)(bp + 4) + acc[ai][bj][m][1];
                    float* p = OUT + off + bj * HALF; *(f32x4*)p = o0; *(f32x4*)(p + 4) = o1;
                    ss += (o0.x * o0.x + o0.y * o0.y) + (o0.z * o0.z + o0.w * o0.w) + (o1.x * o1.x + o1.y * o1.y) + (o1.z * o1.z + o1.w * o1.w);
                    if (HB) { u32x4 w; w.x = cvtpk(o0.x, o0.y); w.y = cvtpk(o0.z, o0.w); w.z = cvtpk(o1.x, o1.y); w.w = cvtpk(o1.z, o1.w); *(u32x4*)(HB + off + bj * HALF) = w; } }
                ss += __shfl_xor(ss, 16); ss += __shfl_xor(ss, 32);
                if (fq == 0) unsafeAtomicAdd(SS + row, ss); }
    }
};
struct EpiFF1 {
    static constexpr bool PERM = true, AFTER_DRAIN = false;
    const float* SS; bf16_t* AB;
    __device__ __forceinline__ void operator()(const f32x4 (&acc)[2][2][4][2], const Unit& u, int wr, int wc, int fr, int fq) const {
        const int row0 = u.pm * BM + wr * 64 + fr, col0 = u.pn * BM + wc * 32 + 8 * fq;
#pragma unroll
        for (int ai = 0; ai < 2; ++ai)
#pragma unroll
            for (int m = 0; m < 4; ++m) { const int row = row0 + ai * HALF + m * 16; const float rs = __builtin_amdgcn_rsqf(SS[row] * (1.0f / 1024.0f) + EPS);
#pragma unroll
                for (int bj = 0; bj < 2; ++bj) { float v[8];
#pragma unroll
                    for (int j = 0; j < 4; ++j) { v[j] = acc[ai][bj][m][0][j]; v[4 + j] = acc[ai][bj][m][1][j]; }
#pragma unroll
                    for (int j = 0; j < 8; ++j) { const float t = fmaxf(v[j] * rs, 0.f); v[j] = t * t; }
                    u32x4 w; w.x = cvtpk(v[0], v[1]); w.y = cvtpk(v[2], v[3]); w.z = cvtpk(v[4], v[5]); w.w = cvtpk(v[6], v[7]);
                    *(u32x4*)(AB + (size_t)row * FF + col0 + bj * HALF) = w; } }
    }
};
}

namespace sb {
__device__ __forceinline__ void unit(int b, int h, int qb, const bf16_t* Q, const bf16_t* __restrict__ K, const bf16_t* __restrict__ V, bf16_t* O, LAS unsigned char* lds) {
    const int tid = threadIdx.x, lane = tid & 63, r32 = lane & 31, hi = lane >> 5; const int wid = __builtin_amdgcn_readfirstlane(tid >> 6);
    const long rowbase = (long)b * SEQ; const int q0 = qb * 256, qw0 = q0 + wid * 32;
    const bf16_t* Qw = Q + (rowbase + qw0) * SBW + h * 64;
    bf16x8 qr[4];
#pragma unroll
    for (int d0 = 0; d0 < 4; ++d0) qr[d0] = *(const bf16x8*)(Qw + (long)r32 * SBW + d0 * 16 + hi * 8);
    bf16x8 tf0, tf1, ones;
#pragma unroll
    for (int j = 0; j < 8; ++j) { const int kk = 8 * (j >> 2) + 4 * hi + (j & 3); tf0[j] = (kk >= r32) ? (short)0x3F80 : (short)0; tf1[j] = (16 + kk >= r32) ? (short)0x3F80 : (short)0; ones[j] = (short)0x3F80; }
    f32x16 o0 = {}, o1 = {}; float carry = 0.f;
    const int NT = (q0 + 256) / 64;
    const bf16_t* kg = K + (rowbase + (tid & 63)) * SBW + h * 64 + (tid >> 6) * 8;
    const int kl = (tid >> 6) * 1024 + (tid & 63) * 16;
    const bf16_t* vg = V + (rowbase + 16 * (wid & 3) + (lane >> 2)) * SBW + h * 64 + (wid >> 2) * 32 + (lane & 3) * 8;
    const int vl = 16384 + wid * 1024 + lane * 16;
    const int vrd = 16384 + ((lane >> 4) & 1) * 32 + (lane & 3) * 8 + (4 * hi + ((lane & 15) >> 2)) * 64;
    u32x4 kreg = *(const u32x4*)(kg + (long)(NT - 1) * 64 * SBW), vreg = *(const u32x4*)(vg + (long)(NT - 1) * 64 * SBW);
    *(LAS u32x4*)(lds + kl) = kreg; *(LAS u32x4*)(lds + vl) = vreg;
    int it = 0;
    for (int t = NT - 1; t >= 0; --t, ++it) {
        const int bo = (it & 1) * 8192;
        __syncthreads();
        if (t > 0) { kreg = *(const u32x4*)(kg + (long)(t - 1) * 64 * SBW); vreg = *(const u32x4*)(vg + (long)(t - 1) * 64 * SBW); }
        const int k0 = 64 * t;
        if (k0 <= qw0 + 30) {
            f32x16 p0 = {}, p1 = {};
            const LAS unsigned char* kb = lds + bo + hi * 1024 + r32 * 16;
#pragma unroll
            for (int d0 = 0; d0 < 4; ++d0) { const bf16x8 a0 = *(const LAS bf16x8*)(kb + d0 * 2048), a1 = *(const LAS bf16x8*)(kb + d0 * 2048 + 512);
                p0 = MFMA32(a0, qr[d0], p0); p1 = MFMA32(a1, qr[d0], p1); }
            if (k0 + 63 >= qw0) { const int qpos = qw0 + r32;
#pragma unroll
                for (int r = 0; r < 16; ++r) { const int key = k0 + crow(r, hi); if (key >= qpos) p0[r] = -INFINITY; if (key + 32 >= qpos) p1[r] = -INFINITY; } }
            f32x16 l0, l1;
#pragma unroll
            for (int r = 0; r < 16; ++r) { l0[r] = -__builtin_amdgcn_logf(1.0f + __builtin_amdgcn_exp2f(p0[r])); l1[r] = -__builtin_amdgcn_logf(1.0f + __builtin_amdgcn_exp2f(p1[r])); }
            const bf16x8 lb0 = pack8(l0, 0), lb1 = pack8(l0, 1), lb2 = pack8(l1, 0), lb3 = pack8(l1, 1);
            f32x16 cv;
#pragma unroll
            for (int r = 0; r < 16; ++r) cv[r] = carry;
            f32x16 i1 = MFMA32(tf0, lb2, cv); i1 = MFMA32(tf1, lb3, i1);
            f32x16 i0 = MFMA32(ones, lb2, cv); i0 = MFMA32(ones, lb3, i0); i0 = MFMA32(tf0, lb0, i0); i0 = MFMA32(tf1, lb1, i0);
            carry = __shfl(i0[0], r32);
#pragma unroll
            for (int r = 0; r < 16; ++r) { p0[r] = __builtin_amdgcn_exp2f(p0[r] + i0[r]); p1[r] = __builtin_amdgcn_exp2f(p1[r] + i1[r]); }
            const bf16x8 pw0 = pack8(p0, 0), pw1 = pack8(p0, 1), pw2 = pack8(p1, 0), pw3 = pack8(p1, 1);
            const LAS unsigned char* vb = lds + vrd + bo;
            { const bf16x8 v0 = trfrag(vb), v1 = trfrag(vb + 1024), v2 = trfrag(vb + 2048), v3 = trfrag(vb + 3072);
              o0 = MFMA32(pw0, v0, o0); o0 = MFMA32(pw1, v1, o0); o0 = MFMA32(pw2, v2, o0); o0 = MFMA32(pw3, v3, o0); }
            { const bf16x8 v0 = trfrag(vb + 4096), v1 = trfrag(vb + 4096 + 1024), v2 = trfrag(vb + 4096 + 2048), v3 = trfrag(vb + 4096 + 3072);
              o1 = MFMA32(pw0, v0, o1); o1 = MFMA32(pw1, v1, o1); o1 = MFMA32(pw2, v2, o1); o1 = MFMA32(pw3, v3, o1); }
        }
        if (t > 0) { const int bn = ((it + 1) & 1) * 8192; *(LAS u32x4*)(lds + bn + kl) = kreg; *(LAS u32x4*)(lds + bn + vl) = vreg; }
    }
    { LAS bf16_t* stg = (LAS bf16_t*)(lds + 32768 + wid * 4096);
#pragma unroll
      for (int r = 0; r < 16; ++r) { const int orow = crow(r, hi); stg[orow * 64 + r32] = cvt1(o0[r]); stg[orow * 64 + 32 + r32] = cvt1(o1[r]); }
      asm volatile("s_waitcnt lgkmcnt(0)" ::: "memory");
      bf16_t* Ow = O + (rowbase + qw0) * SBW + h * 64;
#pragma unroll
      for (int i = 0; i < 4; ++i) { const int row = i * 8 + (lane >> 3), ch = lane & 7; const u32x4 v = *(const LAS u32x4*)(stg + row * 64 + ch * 8); *(u32x4*)(Ow + (long)row * SBW + ch * 8) = v; } }
    __syncthreads();
}
__device__ __forceinline__ void phase(int vcu, int G, const bf16_t* Q, const bf16_t* K, const bf16_t* V, bf16_t* O, LAS unsigned char* lds) {
    for (int p = vcu; p < 256; p += G) { const int bh = p >> 3, s = p & 7;
        unit(bh >> 3, bh & 7, 15 - s, Q, K, V, O, lds);
        unit(bh >> 3, bh & 7, s, Q, K, V, O, lds); }
}
}

namespace hg {
constexpr int IMG = 272;
__device__ __forceinline__ void b1_item(int bh, int c, const float* LF, const bf16_t* I, bf16_t* SL, float* DCH, LAS unsigned char* lds) {
    const int tid = threadIdx.x, lane = tid & 63, r32 = lane & 31, hi = lane >> 5; const int wid = __builtin_amdgcn_readfirstlane(tid >> 6);
    const int b = bh >> 2, h = bh & 3; const long rowc = (long)b * SEQ + c * 64;
    const int d = tid & 127, sc = tid >> 7;
    u32x4 vv[2];
#pragma unroll
    for (int i = 0; i < 2; ++i) { const int idx = tid + 512 * i, s = idx >> 4, ch = idx & 15; vv[i] = *(const u32x4*)(I + (rowc + s) * HGW + h * 128 + ch * 8); }
    float lf[16]; { const float* lp = LF + (rowc + 16 * sc) * HGW + h * 128 + d;
#pragma unroll
        for (int i = 0; i < 16; ++i) lf[i] = lp[(long)i * HGW]; }
    float bc[16]; float run = 0.f;
#pragma unroll
    for (int i = 0; i < 16; ++i) { run += lf[i]; bc[i] = run; }
    LAS float* TOT = (LAS float*)lds; TOT[sc * 128 + d] = run;
    LAS unsigned char* VIMG = lds + 2048; LAS unsigned char* KIMG = lds + 2048 + 16384;
#pragma unroll
    for (int i = 0; i < 2; ++i) { const int idx = tid + 512 * i, s = idx >> 4, e0 = (idx & 15) * 8; *(LAS u32x4*)(VIMG + (e0 >> 5) * 4096 + (s >> 4) * 1024 + (s & 15) * 64 + (e0 & 31) * 2) = vv[i]; }
    __syncthreads();
    const float t0 = TOT[d], t1 = TOT[128 + d], t2 = TOT[256 + d], t3 = TOT[384 + d];
    const float pre = (sc > 0 ? t0 : 0.f) + (sc > 1 ? t1 : 0.f) + (sc > 2 ? t2 : 0.f); const float blast = (t0 + t1) + (t2 + t3);
#pragma unroll
    for (int i = 0; i < 16; ++i) { const int s = 16 * sc + i; const float bcum = bc[i] + pre; const float k = 1.0f - fexp(lf[i]); const float kd = k * fexp(blast - bcum);
        *(LAS bf16_t*)(KIMG + (d >> 5) * 4096 + (s >> 4) * 1024 + (s & 15) * 64 + (d & 31) * 2) = cvt1(kd); }
    if (sc == 0) DCH[(size_t)(bh * 64 + c) * 128 + d] = fexp(blast);
    __syncthreads();
    const int eb = wid >> 1, dbp = (wid & 1) * 2;
    const int laneoff = ((lane >> 4) & 1) * 32 + (lane & 3) * 8 + (4 * hi + ((lane & 15) >> 2)) * 64;
    f32x16 a0 = {}, a1 = {};
#pragma unroll
    for (int ks = 0; ks < 4; ++ks) { const bf16x8 A = trfrag(VIMG + eb * 4096 + ks * 1024 + laneoff), B0 = trfrag(KIMG + dbp * 4096 + ks * 1024 + laneoff), B1 = trfrag(KIMG + (dbp + 1) * 4096 + ks * 1024 + laneoff);
        a0 = MFMA32(A, B0, a0); a1 = MFMA32(A, B1, a1); }
    bf16_t* out = SL + (size_t)(bh * 64 + c) * 16384;
#pragma unroll
    for (int r = 0; r < 16; ++r) { const int e = eb * 32 + crow(r, hi); out[e * 128 + dbp * 32 + r32] = cvt1(a0[r]); out[e * 128 + (dbp + 1) * 32 + r32] = cvt1(a1[r]); }
    __syncthreads();
}
__device__ __forceinline__ void b2_scan(int vcu, int G, bf16_t* SL, const float* DCH) {
    const int tid = threadIdx.x;
    for (int w = vcu; w < 128; w += G) { const int bh = w >> 3, part = w & 7; const int base = (part * 512 + tid) * 4, d = base & 127;
        float s0 = 0.f, s1 = 0.f, s2 = 0.f, s3 = 0.f;
        bf16_t* p = SL + (size_t)bh * 64 * 16384 + base; const float* dp = DCH + (size_t)bh * 64 * 128 + d;
        for (int c0 = 0; c0 < 64; c0 += 8) { u32x2 sv[8]; f32x4 dd[8];
#pragma unroll
            for (int j = 0; j < 8; ++j) { sv[j] = *(const u32x2*)(p + (size_t)(c0 + j) * 16384); dd[j] = *(const f32x4*)(dp + (c0 + j) * 128); }
#pragma unroll
            for (int j = 0; j < 8; ++j) { u32x2 w2; w2.x = cvtpk(s0, s1); w2.y = cvtpk(s2, s3); *(u32x2*)(p + (size_t)(c0 + j) * 16384) = w2;
                s0 = dd[j].x * s0 + __uint_as_float(sv[j].x << 16); s1 = dd[j].y * s1 + __uint_as_float(sv[j].x & 0xffff0000u); s2 = dd[j].z * s2 + __uint_as_float(sv[j].y << 16); s3 = dd[j].w * s3 + __uint_as_float(sv[j].y & 0xffff0000u); } }
    }
}
__device__ __forceinline__ void b3_item(int bh, int c, const float* LF, const bf16_t* QS, const bf16_t* I, const bf16_t* SG, const bf16_t* ST, const float* hgn, bf16_t* OHG, LAS unsigned char* lds) {
    const int tid = threadIdx.x, lane = tid & 63, r32 = lane & 31, hi = lane >> 5; const int wid = __builtin_amdgcn_readfirstlane(tid >> 6);
    const int b = bh >> 2, h = bh & 3; const long rowc = (long)b * SEQ + c * 64;
    const int d = tid & 127, sc = tid >> 7; const int tm = wid >> 2, en = wid & 3;
    bf16x8 sf[8]; { const bf16_t* sp = ST + (size_t)(bh * 64 + c) * 16384 + (en * 32 + r32) * 128 + hi * 8;
#pragma unroll
        for (int ks = 0; ks < 8; ++ks) sf[ks] = *(const bf16x8*)(sp + ks * 16); }
    u32x4 vv[2];
#pragma unroll
    for (int i = 0; i < 2; ++i) { const int idx = tid + 512 * i, s = idx >> 4, ch = idx & 15; vv[i] = *(const u32x4*)(I + (rowc + s) * HGW + h * 128 + ch * 8); }
    float lf[16]; float qv[16]; { const float* lp = LF + (rowc + 16 * sc) * HGW + h * 128 + d; const bf16_t* qp = QS + (rowc + 16 * sc) * HGW + h * 128 + d;
#pragma unroll
        for (int i = 0; i < 16; ++i) { lf[i] = lp[(long)i * HGW]; qv[i] = bf2f(qp[(long)i * HGW]); } }
    float bc[16]; float run = 0.f;
#pragma unroll
    for (int i = 0; i < 16; ++i) { run += lf[i]; bc[i] = run; }
    LAS float* TOT = (LAS float*)lds; TOT[sc * 128 + d] = run;
    LAS unsigned char* QT = lds + 2048; LAS unsigned char* QA = lds + 19456; LAS unsigned char* K1 = lds + 36864; LAS unsigned char* K0 = lds + 54272; LAS unsigned char* VIMG = lds + 62976;
#pragma unroll
    for (int i = 0; i < 2; ++i) { const int idx = tid + 512 * i, s = idx >> 4, e0 = (idx & 15) * 8; *(LAS u32x4*)(VIMG + (e0 >> 5) * 4096 + (s >> 4) * 1024 + (s & 15) * 64 + (e0 & 31) * 2) = vv[i]; }
    __syncthreads();
    { const float t0 = TOT[d], t1 = TOT[128 + d], t2 = TOT[256 + d];
      const float pre = (sc > 0 ? t0 : 0.f) + (sc > 1 ? t1 : 0.f) + (sc > 2 ? t2 : 0.f); const float ref1 = t0 + t1; const float ref = (sc >= 2) ? ref1 : 0.f;
#pragma unroll
      for (int i = 0; i < 16; ++i) { const int s = 16 * sc + i; const float bcum = bc[i] + pre; const float k = 1.0f - fexp(lf[i]); const int off = s * IMG + d * 2;
          *(LAS bf16_t*)(QA + off) = cvt1(qv[i] * fexp(bcum));
          *(LAS bf16_t*)(QT + off) = cvt1(qv[i] * fexp(bcum - ref));
          *(LAS bf16_t*)(K1 + off) = cvt1(k * fexp(fminf(ref1 - bcum, 80.f)));
          if (sc < 2) *(LAS bf16_t*)(K0 + off) = cvt1(k * fexp(fminf(-bcum, 80.f))); } }
    __syncthreads();
    f32x16 o = {};
    { const LAS unsigned char* ap = QA + (32 * tm + r32) * IMG + hi * 16;
#pragma unroll
      for (int ks = 0; ks < 8; ++ks) o = MFMA32(*(const LAS bf16x8*)(ap + ks * 32), sf[ks], o); }
    const int laneoff = ((lane >> 4) & 1) * 32 + (lane & 3) * 8 + (4 * hi + ((lane & 15) >> 2)) * 64;
    const LAS unsigned char* kimg = tm ? K1 : K0;
    const LAS unsigned char* qp2 = QT + (32 * tm + r32) * IMG + hi * 16;
    for (int sh = 0; sh <= tm; ++sh) {
        f32x16 s_ = {};
        const LAS unsigned char* kp = kimg + (32 * sh + r32) * IMG + hi * 16;
#pragma unroll
        for (int ks = 0; ks < 8; ++ks) s_ = MFMA32(*(const LAS bf16x8*)(kp + ks * 32), *(const LAS bf16x8*)(qp2 + ks * 32), s_);
        if (sh == tm) {
#pragma unroll
            for (int r = 0; r < 16; ++r) if (crow(r, hi) > r32) s_[r] = 0.f; }
        const bf16x8 pa = pack8(s_, 0), pb = pack8(s_, 1);
        const bf16x8 vf0 = trfrag(VIMG + en * 4096 + (2 * sh) * 1024 + laneoff), vf1 = trfrag(VIMG + en * 4096 + (2 * sh + 1) * 1024 + laneoff);
        o = MFMA32(pa, vf0, o); o = MFMA32(pb, vf1, o);
    }
    __syncthreads();
    LAS float* OS = (LAS float*)(lds + 2048);
#pragma unroll
    for (int r = 0; r < 16; ++r) OS[(32 * tm + crow(r, hi)) * 132 + en * 32 + r32] = o[r];
    __syncthreads();
    { const int t = tid >> 3, j = tid & 7; float v[16]; float ss = 0.f;
#pragma unroll
      for (int q = 0; q < 4; ++q) { const f32x4 x = *(const LAS f32x4*)(OS + t * 132 + j * 16 + q * 4); v[4 * q] = x.x; v[4 * q + 1] = x.y; v[4 * q + 2] = x.z; v[4 * q + 3] = x.w; ss += (x.x * x.x + x.y * x.y) + (x.z * x.z + x.w * x.w); }
      ss += __shfl_xor(ss, 1); ss += __shfl_xor(ss, 2); ss += __shfl_xor(ss, 4);
      const float rs = __builtin_amdgcn_rsqf(ss * (1.0f / 128.0f) + EPS);
      const size_t go = (size_t)(rowc + t) * HGW + h * 128 + j * 16; const float* gp = hgn + h * 128 + j * 16;
      const u32x4 g0 = *(const u32x4*)(SG + go), g1 = *(const u32x4*)(SG + go + 8);
      const unsigned gw[8] = {g0.x, g0.y, g0.z, g0.w, g1.x, g1.y, g1.z, g1.w}; unsigned ow[8];
#pragma unroll
      for (int q = 0; q < 8; ++q) { const float y0 = v[2 * q] * rs * gp[2 * q] * __uint_as_float(gw[q] << 16), y1 = v[2 * q + 1] * rs * gp[2 * q + 1] * __uint_as_float(gw[q] & 0xffff0000u); ow[q] = cvtpk(y0, y1); }
      *(u32x4*)(OHG + go) = (u32x4){ow[0], ow[1], ow[2], ow[3]}; *(u32x4*)(OHG + go + 8) = (u32x4){ow[4], ow[5], ow[6], ow[7]}; }
    __syncthreads();
}
}

constexpr int NWAVES = 8;
#ifndef MK_PER_PHASE
#define MK_PER_PHASE 0
#endif
constexpr int N_PHASES = 10;
constexpr size_t MiB = 1u << 20;
constexpr size_t WS_SS1 = 0, WS_SS2 = 65536, WS_DCH = 262144;
constexpr size_t WS_WIN = 1 * MiB, WS_WOSB = 12 * MiB, WS_WOHG = 13 * MiB, WS_WOUT = 14 * MiB, WS_WFF1 = 16 * MiB, WS_WFF2 = 24 * MiB;
constexpr size_t WS_XN = 32 * MiB;
constexpr size_t WS_Q = 64 * MiB, WS_K = 80 * MiB, WS_V = 96 * MiB;
constexpr size_t WS_LF = 112 * MiB;
constexpr size_t WS_I = 144 * MiB, WS_QS = 160 * MiB, WS_SG = 176 * MiB, WS_OHG = 192 * MiB;
constexpr size_t WS_HB = 208 * MiB;
constexpr size_t WS_TMP = 112 * MiB;
constexpr size_t WS_AB = 64 * MiB;
constexpr size_t WS_END = 240 * MiB;
constexpr int RING_BYTES = 131072, LDS_BYTES = 147456;

__device__ __forceinline__ float wave_sum(float v) {
#pragma unroll
    for (int o = 1; o < 64; o <<= 1) v += __shfl_xor(v, o);
    return v;
}
__device__ __forceinline__ void p0_transpose_item(const float* W, int K, int N, bf16_t* WT, const float* kscale, LAS float* scr, int item, int lane) {
    const int nblk = N / 32, kb = item / nblk, nb = item % nblk, k0 = 64 * kb, n0 = 32 * nb;
#pragma unroll 8
    for (int i = 0; i < 32; ++i) { const int kk = 2 * i + (lane >> 5); float w = W[(size_t)(k0 + kk) * N + n0 + (lane & 31)]; if (kscale) w *= kscale[k0 + kk]; scr[kk * 33 + (lane & 31)] = w; }
    asm volatile("s_waitcnt lgkmcnt(0)" ::: "memory");
    const int c = lane & 7;
#pragma unroll
    for (int j = 0; j < 4; ++j) { const int n = (lane >> 3) + 8 * j; const LAS float* s = scr + (8 * c) * 33 + n;
        u32x4 o; o.x = cvtpk(s[0 * 33], s[1 * 33]); o.y = cvtpk(s[2 * 33], s[3 * 33]); o.z = cvtpk(s[4 * 33], s[5 * 33]); o.w = cvtpk(s[6 * 33], s[7 * 33]);
        *(u32x4*)(WT + (size_t)(n0 + n) * K + k0 + 8 * c) = o; }
    asm volatile("s_waitcnt lgkmcnt(0)" ::: "memory");
}

struct Args { const float* in[13]; float* out; unsigned char* ws; int ph_lo, ph_hi; };
__global__ void __launch_bounds__(NWAVES * 64, 2) fwd_kernel(Args args) {
    extern __shared__ __attribute__((aligned(16))) unsigned char lds_raw[];
    LAS unsigned char* lds = (LAS unsigned char*)lds_raw;
    const int tid = threadIdx.x, lane = tid & 63, wave = __builtin_amdgcn_readfirstlane(tid >> 6);
    const int G = gridDim.x; const int bx = blockIdx.x; const int vcu = (G % 8 == 0) ? (bx % 8) * (G / 8) + bx / 8 : bx;
    unsigned char* ws = args.ws;
    const float* x = args.in[0]; const float* norm1_g = args.in[1]; const float* w_in = args.in[2]; const float* b_gate = args.in[3]; const float* lb_logits = args.in[4];
    const float* hg_norm_g = args.in[5]; const float* w_o_sb = args.in[6]; const float* w_o_hg = args.in[7]; const float* w_out = args.in[8]; const float* norm2_g = args.in[9];
    const float* w_ff1 = args.in[10]; const float* w_ff2 = args.in[11]; const float* final_g = args.in[12];
    float* out = args.out;
    float* SS1 = (float*)(ws + WS_SS1); float* SS2 = (float*)(ws + WS_SS2); float* DCH = (float*)(ws + WS_DCH);
    bf16_t* WIN = (bf16_t*)(ws + WS_WIN); bf16_t* WOSB = (bf16_t*)(ws + WS_WOSB); bf16_t* WOHG = (bf16_t*)(ws + WS_WOHG); bf16_t* WOUT = (bf16_t*)(ws + WS_WOUT);
    bf16_t* WFF1 = (bf16_t*)(ws + WS_WFF1); bf16_t* WFF2 = (bf16_t*)(ws + WS_WFF2);
    bf16_t* XN = (bf16_t*)(ws + WS_XN); bf16_t* SL = XN; bf16_t* MG = XN;
    bf16_t* QB = (bf16_t*)(ws + WS_Q); bf16_t* KB = (bf16_t*)(ws + WS_K); bf16_t* VB = (bf16_t*)(ws + WS_V); float* LF = (float*)(ws + WS_LF);
    bf16_t* IB = (bf16_t*)(ws + WS_I); bf16_t* QS = (bf16_t*)(ws + WS_QS); bf16_t* SG = (bf16_t*)(ws + WS_SG); bf16_t* OHG = (bf16_t*)(ws + WS_OHG);
    bf16_t* HB = (bf16_t*)(ws + WS_HB); float* TMP = (float*)(ws + WS_TMP); bf16_t* AB = (bf16_t*)(ws + WS_AB);
    bf16_t* GA = (bf16_t*)out; bf16_t* GB = GA + (size_t)M * 1024;
    const int lo = args.ph_lo, hi = args.ph_hi;
#define IN(k) (lo <= (k) && (k) < hi)
#define SEAM(k) do { if (IN(k) && IN((k) + 1)) { __threadfence(); cg::this_grid().sync(); } } while (0)

    if (IN(0)) {
        LAS float* scr = (LAS float*)(lds + wave * 16384);
        const int gw = vcu * NWAVES + wave, NGW = G * NWAVES;
        constexpr int I_IN = (DM / 64) * (NIN / 32), I_OS = (512 / 64) * (DM / 32), I_OUT = (DM / 64) * (DM / 32), I_F1 = (DM / 64) * (FF / 32), I_F2 = (FF / 64) * (DM / 32);
        constexpr int NITEMS = I_IN + 2 * I_OS + I_OUT + I_F1 + I_F2;
        for (int it = gw; it < NITEMS; it += NGW) { int r = it;
            if (r < I_IN) { p0_transpose_item(w_in, DM, NIN, WIN, nullptr, scr, r, lane); continue; } r -= I_IN;
            if (r < I_OS) { p0_transpose_item(w_o_sb, 512, DM, WOSB, nullptr, scr, r, lane); continue; } r -= I_OS;
            if (r < I_OS) { p0_transpose_item(w_o_hg, 512, DM, WOHG, nullptr, scr, r, lane); continue; } r -= I_OS;
            if (r < I_OUT) { p0_transpose_item(w_out, DM, DM, WOUT, nullptr, scr, r, lane); continue; } r -= I_OUT;
            if (r < I_F1) { p0_transpose_item(w_ff1, DM, FF, WFF1, norm2_g, scr, r, lane); continue; } r -= I_F1;
            p0_transpose_item(w_ff2, FF, DM, WFF2, nullptr, scr, r, lane); }
        for (int m = gw; m < M; m += NGW) { const f32x4* xr = (const f32x4*)(x + (size_t)m * DM) + lane; f32x4 v[4]; float s = 0.f;
#pragma unroll
            for (int j = 0; j < 4; ++j) { v[j] = xr[64 * j]; s += (v[j].x * v[j].x + v[j].y * v[j].y) + (v[j].z * v[j].z + v[j].w * v[j].w); }
            const float rs = __builtin_amdgcn_rsqf(wave_sum(s) * (1.0f / DM) + EPS);
            u32x2* o8 = (u32x2*)(XN + (size_t)m * DM) + lane;
#pragma unroll
            for (int j = 0; j < 4; ++j) { const f32x4 g = ((const f32x4*)norm1_g)[lane + 64 * j]; u32x2 w; w.x = cvtpk(v[j].x * rs * g.x, v[j].y * rs * g.y); w.y = cvtpk(v[j].z * rs * g.z, v[j].w * rs * g.w); o8[64 * j] = w; } }
        for (int i = bx * 512 + tid; i < 2 * M; i += G * 512) { if (i < M) SS1[i] = 0.f; else SS2[i - M] = 0.f; }
    }
    SEAM(0);
    if (IN(1)) { pg8::Gemm g{XN, WIN, M, NIN, DM}; pg8::StaticOrder S; S.init(M, NIN, G, bx);
        pg8::EpiIn E{QB, KB, VB, IB, QS, SG, GA, GB, LF, lb_logits, b_gate};
        pg8::gemm_phase<pg8::EpiIn, pg8::StaticOrder, true, true>(lds, g, S, E); }
    SEAM(1);
    if (IN(2)) { for (int it = vcu; it < 1024; it += G) hg::b1_item(it >> 6, it & 63, LF, IB, SL, DCH, lds); }
    SEAM(2);
    if (IN(3)) { hg::b2_scan(vcu, G, SL, DCH); sb::phase(vcu, G, QB, KB, VB, QB, lds); }
    SEAM(3);
    if (IN(4)) { for (int it = vcu; it < 1024; it += G) hg::b3_item(it >> 6, it & 63, LF, QS, IB, SG, SL, hg_norm_g, OHG, lds); }
    SEAM(4);
    if (IN(5)) {
        { pg8::Gemm g{QB, WOSB, M, DM, 512}; pg8::StaticOrder S; S.init(M, DM, G, bx); pg8::EpiM1 E{GA, TMP}; pg8::gemm_phase<pg8::EpiM1, pg8::StaticOrder, true, true>(lds, g, S, E); }
        { pg8::Gemm g{OHG, WOHG, M, DM, 512}; pg8::StaticOrder S; S.init(M, DM, G, bx); pg8::EpiM2 E{GB, TMP, MG}; pg8::gemm_phase<pg8::EpiM2, pg8::StaticOrder, true, true>(lds, g, S, E); }
    }
    SEAM(5);
    if (IN(6)) { pg8::Gemm g{MG, WOUT, M, DM, DM}; pg8::StaticOrder S; S.init(M, DM, G, bx); pg8::EpiRes E{x, out, HB, SS1}; pg8::gemm_phase<pg8::EpiRes, pg8::StaticOrder, true, true>(lds, g, S, E); }
    SEAM(6);
    if (IN(7)) { pg8::Gemm g{HB, WFF1, M, FF, DM}; pg8::StaticOrder S; S.init(M, FF, G, bx); pg8::EpiFF1 E{SS1, AB}; pg8::gemm_phase<pg8::EpiFF1, pg8::StaticOrder, true, true>(lds, g, S, E); }
    SEAM(7);
    if (IN(8)) { pg8::Gemm g{AB, WFF2, M, DM, FF}; pg8::StaticOrder S; S.init(M, DM, G, bx); pg8::EpiRes E{out, out, nullptr, SS2}; pg8::gemm_phase<pg8::EpiRes, pg8::StaticOrder, true, true>(lds, g, S, E); }
    SEAM(8);
    if (IN(9)) { const int gw = vcu * NWAVES + wave, NGW = G * NWAVES;
        for (int m = gw; m < M; m += NGW) { f32x4* xr = (f32x4*)(out + (size_t)m * DM) + lane; const float rs = __builtin_amdgcn_rsqf(SS2[m] * (1.0f / DM) + EPS);
#pragma unroll
            for (int j = 0; j < 4; ++j) { const f32x4 g = ((const f32x4*)final_g)[lane + 64 * j]; f32x4 v = xr[64 * j]; v.x *= rs * g.x; v.y *= rs * g.y; v.z *= rs * g.z; v.w *= rs * g.w; xr[64 * j] = v; } } }
#undef IN
#undef SEAM
}

extern "C" void kernel_launch(void* const* d_in, const int* in_sizes, int n_in, void* d_out, int out_size, void* d_ws, size_t ws_size, hipStream_t stream) {
    static int grid = 0;
    if (grid == 0) {
        if (n_in != 13 || out_size != M * DM || ws_size < WS_END) { fprintf(stderr, "kernel_launch: unexpected problem (n_in %d out %d ws %zu)\n", n_in, out_size, ws_size); grid = -1; return; }
        int dev = 0, cus = 0, per_cu = 0;
        if (hipGetDevice(&dev) != hipSuccess || hipDeviceGetAttribute(&cus, hipDeviceAttributeMultiprocessorCount, dev) != hipSuccess) { grid = -1; return; }
        if (hipFuncSetAttribute((const void*)fwd_kernel, hipFuncAttributeMaxDynamicSharedMemorySize, LDS_BYTES) != hipSuccess) { fprintf(stderr, "kernel_launch: hipFuncSetAttribute failed\n"); grid = -1; return; }
        if (hipOccupancyMaxActiveBlocksPerMultiprocessor(&per_cu, (const void*)fwd_kernel, NWAVES * 64, LDS_BYTES) != hipSuccess || per_cu < 1) { fprintf(stderr, "kernel_launch: occupancy query says %d\n", per_cu); per_cu = 1; }
        (void)hipGetLastError();
        grid = cus;
    }
    if (grid < 0) return;
    Args a{};
    for (int i = 0; i < 13; ++i) a.in[i] = (const float*)d_in[i];
    a.out = (float*)d_out; a.ws = (unsigned char*)d_ws;
#if MK_PER_PHASE
    for (int p = 0; p < N_PHASES; ++p) { a.ph_lo = p; a.ph_hi = p + 1; hipLaunchKernelGGL(fwd_kernel, dim3(grid), dim3(NWAVES * 64), LDS_BYTES, stream, a); }
#else
    a.ph_lo = 0; a.ph_hi = N_PHASES;
    void* kargs[] = {&a};
    const hipError_t e = hipLaunchCooperativeKernel((const void*)fwd_kernel, dim3(grid), dim3(NWAVES * 64), kargs, LDS_BYTES, stream);
    if (e != hipSuccess) fprintf(stderr, "kernel_launch: cooperative launch failed: %s (grid %d)\n", hipGetErrorString(e), grid);
#endif
}
```

```cpp
#include <hip/hip_runtime.h>
#include <hip/hip_cooperative_groups.h>
#include <cstdio>
#include <cstdint>
#include <cmath>
namespace cg = cooperative_groups;
namespace pg8 {
#define PG8_LAS __attribute__((address_space(3)))
typedef unsigned short bf16_t;
typedef short bf16x8 __attribute__((ext_vector_type(8)));
typedef float f32x4 __attribute__((ext_vector_type(4)));
typedef unsigned u32x4 __attribute__((ext_vector_type(4)));
constexpr int BM = 256, BK = 64, HALF = 128, HTB = HALF * BK * 2  , STAGE_BYTES = 8 * HTB, NXCD = 8, WGM = 8;

__host__ __device__ __forceinline__ int lds_byte(int r, int c) { const int st = (r >> 4) * 2 + (c >> 5), rr = r & 15, cc = c & 31, ob = rr * 64 + cc * 2; return st * 1024 + (ob ^ (((ob >> 9) & 1) << 5)); }
__host__ __device__ __forceinline__ void stage_rc(int b, int& R, int& C) { const int st = b / 1024, sb = b % 1024, swz = sb ^ (((sb >> 9) & 1) << 5); R = (st >> 1) * 16 + swz / 64; C = (st & 1) * 32 + (swz % 64) / 2; }
__host__ __device__ __forceinline__ int perm32(int rho) { const int n = rho >> 4, i = rho & 15; return 8 * (i >> 2) + 4 * n + (i & 3); }

struct Unit { int pm, pn; };
struct Gemm { const bf16_t* A; const bf16_t* Bt; int M, N, K; };

struct StaticOrder {
    int nM, nN, nwg, G, c;
    __host__ __device__ void init(int M, int N, int G_, int c_) { nM = M / BM; nN = N / BM; nwg = nM * nN; G = G_; c = c_; }
    __host__ __device__ bool next(int i, Unit& u) const {
        const long L = (long)i * G + c; if (L >= nwg) return false;
        int wgid = (int)L; { const int q = nwg / NXCD, r = nwg % NXCD, xcd = wgid % NXCD, off = wgid / NXCD; wgid = (xcd < r ? xcd * (q + 1) : r * (q + 1) + (xcd - r) * q) + off; }
        const int nig = WGM * nN, gid = wgid / nig, fm = gid * WGM, gsz = (nM - fm) < WGM ? (nM - fm) : WGM;
        u.pm = fm + ((wgid % nig) % gsz); u.pn = (wgid % nig) / gsz; return true;
    }
    __device__ __forceinline__ void a_ready(const Unit&) const {}
    __device__ __forceinline__ void done(const Unit&) const {}
};

__device__ __forceinline__ unsigned cvt_pk_bf16(float lo, float hi) { unsigned r; asm volatile("v_cvt_pk_bf16_f32 %0, %1, %2" : "=v"(r) : "v"(lo), "v"(hi)); return r; }
typedef float f32x2 __attribute__((ext_vector_type(2)));
template <class Epi, class Sched, bool ALIGN_EPI = false, bool SP2 = false>
__device__ __forceinline__ void gemm_phase(PG8_LAS unsigned char* lds, const Gemm g, const Sched& S, const Epi& E) {
    const int tid = threadIdx.x, wid = __builtin_amdgcn_readfirstlane(tid >> 6), lane = tid & 63, wr = wid >> 2, wc = wid & 3, fr = lane & 15, fq = lane >> 4;
    const int K = g.K, nt = K / BK;
    unsigned voffA[2], voffB[2];
#pragma unroll
    for (int i = 0; i < 2; ++i) { int R, C; stage_rc(tid * 16 + i * 8192, R, C); const int Rb = Epi::PERM ? ((R & ~31) + perm32(R & 31)) : R;
        voffA[i] = (unsigned)(R * K + C) * 2u; voffB[i] = (unsigned)(Rb * K + C) * 2u; }
    const size_t kstep = (size_t)(BK * 2);
    const size_t hstep = (size_t)HALF * K * 2;
    const size_t tstep = 2 * hstep;
    const unsigned ldsw = (unsigned)wid * 1024u;
    const int aoff = lds_byte(wr * 64 + fr, fq * 8), boff = lds_byte(wc * 32 + fr, fq * 8);
#define PG8_SA(b, h) (((b) * 2 + (h)) * HTB)
#define PG8_SB(b, h) ((4 + (b) * 2 + (h)) * HTB)
#define PG8_STAGE(bufoff, gbase, voff) do { _Pragma("unroll") for (int _i = 0; _i < 2; ++_i) \
        __builtin_amdgcn_global_load_lds((const unsigned*)((const char*)(gbase) + (voff)[_i]), (PG8_LAS unsigned*)(lds + (bufoff) + ldsw + _i * 8192), 16, 0, 0); } while (0)
#define PG8_LDA(dst, b, h) do { _Pragma("unroll") for (int m = 0; m < 4; ++m) _Pragma("unroll") for (int k = 0; k < 2; ++k) dst[m][k] = *(const PG8_LAS bf16x8*)(lds + PG8_SA(b, h) + aoff + m * 2048 + k * 1024); } while (0)
#define PG8_LDB(dst, b, h) do { _Pragma("unroll") for (int n = 0; n < 2; ++n) _Pragma("unroll") for (int k = 0; k < 2; ++k) dst[n][k] = *(const PG8_LAS bf16x8*)(lds + PG8_SB(b, h) + boff + n * 2048 + k * 1024); } while (0)
#define PG8_MMA(ai, bj, At, Bt) do { __builtin_amdgcn_s_setprio(1); _Pragma("unroll") for (int m = 0; m < 4; ++m) _Pragma("unroll") for (int n = 0; n < 2; ++n) _Pragma("unroll") for (int k = 0; k < 2; ++k) \
        acc[ai][bj][m][n] = __builtin_amdgcn_mfma_f32_16x16x32_bf16(Bt[n][k], At[m][k], acc[ai][bj][m][n], 0, 0, 0); __builtin_amdgcn_s_setprio(0); } while (0)
#define PG8_WAIT_V(n) asm volatile("s_waitcnt vmcnt(" #n ")" ::: "memory")
#define PG8_WAIT_L(n) asm volatile("s_waitcnt lgkmcnt(" #n ")" ::: "memory")
#define PG8_BAR __builtin_amdgcn_s_barrier()
#define PG8_SCHED __builtin_amdgcn_sched_barrier(0)
    Unit cur, nxt; int ui = 0;
    if (!S.next(0, cur)) return;
    f32x4 acc[2][2][4][2];
#pragma unroll
    for (int a = 0; a < 2; ++a)
#pragma unroll
        for (int b = 0; b < 2; ++b)
#pragma unroll
            for (int m = 0; m < 4; ++m)
#pragma unroll
                for (int n = 0; n < 2; ++n) acc[a][b][m][n] = (f32x4){0.f, 0.f, 0.f, 0.f};
    bf16x8 At[4][2], B0[2][2], B1[2][2];
    const char* cA = (const char*)g.A + (size_t)cur.pm * tstep; const char* cB = (const char*)g.Bt + (size_t)cur.pn * tstep;
    S.a_ready(cur);
    if constexpr (SP2) {
        PG8_STAGE(PG8_SB(0, 0), cB, voffB); PG8_STAGE(PG8_SB(0, 1), cB + hstep, voffB); PG8_STAGE(PG8_SA(0, 0), cA, voffA); PG8_STAGE(PG8_SA(0, 1), cA + hstep, voffA);
        if (wr == 1) PG8_BAR;
        PG8_WAIT_V(2); PG8_BAR;
        PG8_STAGE(PG8_SB(1, 0), cB + kstep, voffB); PG8_STAGE(PG8_SA(1, 0), cA + kstep, voffA); PG8_STAGE(PG8_SB(1, 1), cB + hstep + kstep, voffB);
        PG8_WAIT_V(6); PG8_BAR;
    } else {
        PG8_STAGE(PG8_SB(0, 0), cB, voffB); PG8_STAGE(PG8_SA(0, 0), cA, voffA); PG8_STAGE(PG8_SB(0, 1), cB + hstep, voffB); PG8_STAGE(PG8_SA(0, 1), cA + hstep, voffA);
        if (wr == 1) PG8_BAR;
        PG8_WAIT_V(4); PG8_BAR;
        PG8_STAGE(PG8_SB(1, 0), cB + kstep, voffB); PG8_STAGE(PG8_SA(1, 0), cA + kstep, voffA); PG8_STAGE(PG8_SB(1, 1), cB + hstep + kstep, voffB);
        PG8_WAIT_V(6); PG8_BAR;
    }
    for (;;) {
        const bool has_next = S.next(ui + 1, nxt);
        const char* nA = has_next ? (const char*)g.A + (size_t)nxt.pm * tstep : cA; const char* nB = has_next ? (const char*)g.Bt + (size_t)nxt.pn * tstep : cB;
        for (int t = 0; t < nt; t += 2) {
            const bool last = (t == nt - 2);
            const char* a1 = cA + (size_t)(t + 1) * kstep;
            const char* a2 = last ? nA : cA + (size_t)(t + 2) * kstep; const char* b2 = last ? nB : cB + (size_t)(t + 2) * kstep;
            const char* a3 = a2 + kstep; const char* b3 = b2 + kstep;
            if (last && has_next) S.a_ready(nxt);
            if constexpr (SP2) {
            PG8_LDB(B0, 0, 0); PG8_LDB(B1, 0, 1); PG8_SCHED; PG8_LDA(At, 0, 0); PG8_STAGE(PG8_SA(1, 1), a1 + hstep, voffA);
            PG8_WAIT_V(8); PG8_WAIT_L(0); PG8_BAR; PG8_MMA(0, 0, At, B0); PG8_MMA(0, 1, At, B1); PG8_BAR; PG8_SCHED;
            PG8_LDA(At, 0, 1); PG8_STAGE(PG8_SB(0, 0), b2, voffB); PG8_STAGE(PG8_SB(0, 1), b2 + hstep, voffB); PG8_STAGE(PG8_SA(0, 0), a2, voffA);
            PG8_WAIT_V(8); PG8_WAIT_L(0); PG8_BAR; PG8_MMA(1, 0, At, B0); PG8_MMA(1, 1, At, B1); PG8_BAR; PG8_SCHED;
            PG8_LDB(B0, 1, 0); PG8_LDB(B1, 1, 1); PG8_SCHED; PG8_LDA(At, 1, 0); PG8_STAGE(PG8_SA(0, 1), a2 + hstep, voffA);
            PG8_WAIT_V(8); PG8_WAIT_L(0); PG8_BAR; PG8_MMA(0, 0, At, B0); PG8_MMA(0, 1, At, B1); PG8_BAR; PG8_SCHED;
            PG8_LDA(At, 1, 1); PG8_STAGE(PG8_SB(1, 0), b3, voffB); PG8_STAGE(PG8_SB(1, 1), b3 + hstep, voffB); PG8_STAGE(PG8_SA(1, 0), a3, voffA);
            PG8_WAIT_V(8); PG8_WAIT_L(0); PG8_BAR; PG8_MMA(1, 0, At, B0); PG8_MMA(1, 1, At, B1); PG8_BAR; PG8_SCHED;
            } else {
            PG8_LDB(B0, 0, 0); PG8_SCHED; PG8_LDA(At, 0, 0); PG8_STAGE(PG8_SA(1, 1), a1 + hstep, voffA);
            PG8_WAIT_L(8); PG8_BAR; PG8_WAIT_L(0); PG8_MMA(0, 0, At, B0); PG8_BAR; PG8_SCHED;
            PG8_LDB(B1, 0, 1); PG8_STAGE(PG8_SB(0, 0), b2, voffB);
            PG8_BAR; PG8_WAIT_L(0); PG8_MMA(0, 1, At, B1); PG8_BAR;
            PG8_LDA(At, 0, 1); PG8_STAGE(PG8_SA(0, 0), a2, voffA);
            PG8_BAR; PG8_WAIT_L(0); PG8_MMA(1, 0, At, B0); PG8_BAR; PG8_SCHED;
            PG8_STAGE(PG8_SB(0, 1), b2 + hstep, voffB);
            PG8_WAIT_V(6); PG8_BAR; PG8_MMA(1, 1, At, B1); PG8_BAR;
            PG8_LDB(B0, 1, 0); PG8_SCHED; PG8_LDA(At, 1, 0); PG8_STAGE(PG8_SA(0, 1), a2 + hstep, voffA);
            PG8_WAIT_L(8); PG8_BAR; PG8_WAIT_L(0); PG8_MMA(0, 0, At, B0); PG8_BAR; PG8_SCHED;
            PG8_LDB(B1, 1, 1); PG8_STAGE(PG8_SB(1, 0), b3, voffB);
            PG8_BAR; PG8_WAIT_L(0); PG8_MMA(0, 1, At, B1); PG8_BAR;
            PG8_LDA(At, 1, 1); PG8_STAGE(PG8_SA(1, 0), a3, voffA);
            PG8_BAR; PG8_WAIT_L(0); PG8_MMA(1, 0, At, B0); PG8_BAR; PG8_SCHED;
            PG8_STAGE(PG8_SB(1, 1), b3 + hstep, voffB);
            PG8_WAIT_V(6); PG8_BAR; PG8_MMA(1, 1, At, B1); PG8_BAR;
            }
        }
        if constexpr (ALIGN_EPI) { if (wr == 0) PG8_BAR; }
        if constexpr (!Epi::AFTER_DRAIN) { E(acc, cur, wr, wc, fr, fq); S.done(cur); }
        if (!has_next) break;
#pragma unroll
        for (int a = 0; a < 2; ++a)
#pragma unroll
            for (int b = 0; b < 2; ++b)
#pragma unroll
                for (int m = 0; m < 4; ++m)
#pragma unroll
                    for (int n = 0; n < 2; ++n) acc[a][b][m][n] = (f32x4){0.f, 0.f, 0.f, 0.f};
        cur = nxt; cA = nA; cB = nB; ++ui;
        if constexpr (ALIGN_EPI) { if (wr == 1) PG8_BAR; }
    }
    PG8_WAIT_V(0);
    if constexpr (!ALIGN_EPI) { if (wr == 0) PG8_BAR; }
    PG8_BAR;
    if constexpr (Epi::AFTER_DRAIN) { E.fused(acc, cur, wr, wc, fr, fq, lds, wid, lane); S.done(cur); }
#undef PG8_SA
#undef PG8_SB
#undef PG8_STAGE
#undef PG8_LDA
#undef PG8_LDB
#undef PG8_MMA
#undef PG8_WAIT_V
#undef PG8_WAIT_L
#undef PG8_BAR
#undef PG8_SCHED
}
}

constexpr int BATCH = 4, SEQ = 4096, DM = 1024, M = BATCH * SEQ, NIN = 5632, FF = 4096, SBW = 512, HGW = 512;
constexpr float EPS = 1e-6f;
constexpr float QSCALE = 0.125f * 1.4426950408889634f;
#define LAS __attribute__((address_space(3)))
typedef unsigned short bf16_t;
typedef short bf16x8 __attribute__((ext_vector_type(8)));
typedef short s16x4 __attribute__((ext_vector_type(4)));
typedef float f32x4 __attribute__((ext_vector_type(4)));
typedef float f32x16 __attribute__((ext_vector_type(16)));
typedef unsigned u32x4 __attribute__((ext_vector_type(4)));
typedef unsigned u32x2 __attribute__((ext_vector_type(2)));
typedef float f32x2_t __attribute__((ext_vector_type(2)));
typedef __bf16 bf16x2_t __attribute__((ext_vector_type(2)));
__device__ __forceinline__ unsigned cvtpk(float lo, float hi) { f32x2_t v = {lo, hi}; bf16x2_t b = __builtin_convertvector(v, bf16x2_t); return __builtin_bit_cast(unsigned, b); }
__device__ __forceinline__ bf16_t cvt1(float x) { return (bf16_t)(cvtpk(x, 0.f) & 0xffffu); }
__device__ __forceinline__ float bf2f(bf16_t b) { return __uint_as_float(((unsigned)b) << 16); }
__device__ __forceinline__ float fexp(float x) { return __builtin_amdgcn_exp2f(x * 1.4426950408889634f); }
__device__ __forceinline__ float fsigmoid(float x) { return __builtin_amdgcn_rcpf(1.0f + __builtin_amdgcn_exp2f(-x * 1.4426950408889634f)); }
__device__ __forceinline__ int crow(int r, int hi) { return (r & 3) + 8 * (r >> 2) + 4 * hi; }
__device__ __forceinline__ bf16x8 pack8(const f32x16& x, int s) {
    u32x4 p; p.x = cvtpk(x[8 * s + 0], x[8 * s + 1]); p.y = cvtpk(x[8 * s + 2], x[8 * s + 3]); p.z = cvtpk(x[8 * s + 4], x[8 * s + 5]); p.w = cvtpk(x[8 * s + 6], x[8 * s + 7]);
    return __builtin_bit_cast(bf16x8, p);
}
#define MFMA32(a, b, c) __builtin_amdgcn_mfma_f32_32x32x16_bf16((a), (b), (c), 0, 0, 0)
typedef short v4i16_t __attribute__((ext_vector_type(4)));
__device__ __forceinline__ bf16x8 trfrag(const LAS unsigned char* p) {
    const s16x4 lo = __builtin_bit_cast(s16x4, __builtin_amdgcn_ds_read_tr16_b64_v4i16((LAS v4i16_t*)p));
    const s16x4 hi = __builtin_bit_cast(s16x4, __builtin_amdgcn_ds_read_tr16_b64_v4i16((LAS v4i16_t*)(p + 512)));
    return (bf16x8){lo[0], lo[1], lo[2], lo[3], hi[0], hi[1], hi[2], hi[3]};
}

namespace pg8 {
struct EpiIn {
    static constexpr bool PERM = true, AFTER_DRAIN = false;
    bf16_t *Q, *K, *V, *I, *QS, *SG, *GA, *GB; float* LF; const float* lbl; const float* bg;
    template <int MODE> __device__ __forceinline__ void body(const f32x4 (&acc)[2][2][4][2], bf16_t* dst, int ldc, int row0, int col0, const float (&aux)[2][8]) const {
#pragma unroll
        for (int ai = 0; ai < 2; ++ai)
#pragma unroll
            for (int m = 0; m < 4; ++m) { const size_t row = (size_t)(row0 + ai * HALF + m * 16);
#pragma unroll
                for (int bj = 0; bj < 2; ++bj) { float v[8];
#pragma unroll
                    for (int j = 0; j < 4; ++j) { v[j] = acc[ai][bj][m][0][j]; v[4 + j] = acc[ai][bj][m][1][j]; }
#pragma unroll
                    for (int j = 0; j < 8; ++j) {
                        if (MODE == 0) v[j] *= QSCALE;
                        if (MODE == 2) { const float sg = fsigmoid(v[j]); const float f = aux[bj][j] + (1.0f - aux[bj][j]) * sg; v[j] = __logf(f); }
                        if (MODE == 3) v[j] = v[j] * fsigmoid(v[j]);
                        if (MODE == 4) v[j] = fsigmoid(v[j] + aux[bj][j]);
                    }
                    if (MODE == 2) { float* p = LF + row * 512 + col0 + bj * HALF; *(f32x4*)p = (f32x4){v[0], v[1], v[2], v[3]}; *(f32x4*)(p + 4) = (f32x4){v[4], v[5], v[6], v[7]}; }
                    else { u32x4 w; w.x = cvtpk(v[0], v[1]); w.y = cvtpk(v[2], v[3]); w.z = cvtpk(v[4], v[5]); w.w = cvtpk(v[6], v[7]); *(u32x4*)(dst + row * ldc + col0 + bj * HALF) = w; }
                } }
    }
    __device__ __forceinline__ void operator()(const f32x4 (&acc)[2][2][4][2], const Unit& u, int wr, int wc, int fr, int fq) const {
        const int pn = u.pn; const int row0 = u.pm * BM + wr * 64 + fr; const int cw = wc * 32 + 8 * fq;
        float aux[2][8];
#pragma unroll
        for (int bj = 0; bj < 2; ++bj)
#pragma unroll
            for (int j = 0; j < 8; ++j) aux[bj][j] = 0.f;
        if (pn < 2) body<0>(acc, Q, 512, row0, pn * 256 + cw, aux);
        else if (pn < 4) body<1>(acc, K, 512, row0, (pn - 2) * 256 + cw, aux);
        else if (pn < 6) body<1>(acc, V, 512, row0, (pn - 4) * 256 + cw, aux);
        else if (pn < 8) { const int c0 = (pn - 6) * 256 + cw;
#pragma unroll
            for (int bj = 0; bj < 2; ++bj)
#pragma unroll
                for (int j = 0; j < 8; ++j) { const int c = c0 + bj * HALF + j; aux[bj][j] = __builtin_amdgcn_rcpf(1.0f + fexp(lbl[512 + c] - lbl[c])); }
            body<2>(acc, nullptr, 512, row0, c0, aux); }
        else if (pn < 10) body<1>(acc, I, 512, row0, (pn - 8) * 256 + cw, aux);
        else if (pn < 12) body<3>(acc, QS, 512, row0, (pn - 10) * 256 + cw, aux);
        else if (pn < 14) body<3>(acc, SG, 512, row0, (pn - 12) * 256 + cw, aux);
        else { const bool second = pn >= 18; const int c0 = (pn - (second ? 18 : 14)) * 256 + cw;
#pragma unroll
            for (int bj = 0; bj < 2; ++bj)
#pragma unroll
                for (int j = 0; j < 8; ++j) aux[bj][j] = bg[(second ? 1024 : 0) + c0 + bj * HALF + j];
            body<4>(acc, second ? GB : GA, 1024, row0, c0, aux); }
    }
};
struct EpiM1 {
    static constexpr bool PERM = true, AFTER_DRAIN = false;
    const bf16_t* GA; float* TMP;
    __device__ __forceinline__ void operator()(const f32x4 (&acc)[2][2][4][2], const Unit& u, int wr, int wc, int fr, int fq) const {
        const int row0 = u.pm * BM + wr * 64 + fr, col0 = u.pn * BM + wc * 32 + 8 * fq;
#pragma unroll
        for (int ai = 0; ai < 2; ++ai)
#pragma unroll
            for (int m = 0; m < 4; ++m) { const size_t off = (size_t)(row0 + ai * HALF + m * 16) * 1024 + col0;
#pragma unroll
                for (int bj = 0; bj < 2; ++bj) { const u32x4 g = *(const u32x4*)(GA + off + bj * HALF); const f32x4 a0 = acc[ai][bj][m][0], a1 = acc[ai][bj][m][1];
                    f32x4 o0, o1; o0.x = a0.x * __uint_as_float(g.x << 16); o0.y = a0.y * __uint_as_float(g.x & 0xffff0000u); o0.z = a0.z * __uint_as_float(g.y << 16); o0.w = a0.w * __uint_as_float(g.y & 0xffff0000u);
                    o1.x = a1.x * __uint_as_float(g.z << 16); o1.y = a1.y * __uint_as_float(g.z & 0xffff0000u); o1.z = a1.z * __uint_as_float(g.w << 16); o1.w = a1.w * __uint_as_float(g.w & 0xffff0000u);
                    float* p = TMP + off + bj * HALF; *(f32x4*)p = o0; *(f32x4*)(p + 4) = o1; } }
    }
};
struct EpiM2 {
    static constexpr bool PERM = true, AFTER_DRAIN = false;
    const bf16_t* GB; const float* TMP; bf16_t* MG;
    __device__ __forceinline__ void operator()(const f32x4 (&acc)[2][2][4][2], const Unit& u, int wr, int wc, int fr, int fq) const {
        const int row0 = u.pm * BM + wr * 64 + fr, col0 = u.pn * BM + wc * 32 + 8 * fq;
#pragma unroll
        for (int ai = 0; ai < 2; ++ai)
#pragma unroll
            for (int m = 0; m < 4; ++m) { const size_t off = (size_t)(row0 + ai * HALF + m * 16) * 1024 + col0;
#pragma unroll
                for (int bj = 0; bj < 2; ++bj) { const u32x4 g = *(const u32x4*)(GB + off + bj * HALF); const f32x4 a0 = acc[ai][bj][m][0], a1 = acc[ai][bj][m][1];
                    const float* p = TMP + off + bj * HALF; const f32x4 t0 = *(const f32x4*)p, t1 = *(const f32x4*)(p + 4);
                    f32x4 o0, o1; o0.x = t0.x + a0.x * __uint_as_float(g.x << 16); o0.y = t0.y + a0.y * __uint_as_float(g.x & 0xffff0000u); o0.z = t0.z + a0.z * __uint_as_float(g.y << 16); o0.w = t0.w + a0.w * __uint_as_float(g.y & 0xffff0000u);
                    o1.x = t1.x + a1.x * __uint_as_float(g.z << 16); o1.y = t1.y + a1.y * __uint_as_float(g.z & 0xffff0000u); o1.z = t1.z + a1.z * __uint_as_float(g.w << 16); o1.w = t1.w + a1.w * __uint_as_float(g.w & 0xffff0000u);
                    u32x4 w; w.x = cvtpk(o0.x, o0.y); w.y = cvtpk(o0.z, o0.w); w.z = cvtpk(o1.x, o1.y); w.w = cvtpk(o1.z, o1.w); *(u32x4*)(MG + off + bj * HALF) = w; } }
    }
};
struct EpiRes {
    static constexpr bool PERM = true, AFTER_DRAIN = false;
    const float* BASE; float* OUT; bf16_t* HB; float* SS;
    __device__ __forceinline__ void operator()(const f32x4 (&acc)[2][2][4][2], const Unit& u, int wr, int wc, int fr, int fq) const {
        const int row0 = u.pm * BM + wr * 64 + fr, col0 = u.pn * BM + wc * 32 + 8 * fq;
#pragma unroll
        for (int ai = 0; ai < 2; ++ai)
#pragma unroll
            for (int m = 0; m < 4; ++m) { const int row = row0 + ai * HALF + m * 16; const size_t off = (size_t)row * 1024 + col0; float ss = 0.f;
#pragma unroll
                for (int bj = 0; bj < 2; ++bj) { const float* bp = BASE + off + bj * HALF; const f32x4 o0 = *(const f32x4*)bp + acc[ai][bj][m][0], o1 = *(const f32x4*)(bp + 4) + acc[ai][bj][m][1];
                    float* p = OUT + off + bj * HALF; *(f32x4*)p = o0; *(f32x4*)(p + 4) = o1;
                    ss += (o0.x * o0.x + o0.y * o0.y) + (o0.z * o0.z + o0.w * o0.w) + (o1.x * o1.x + o1.y * o1.y) + (o1.z * o1.z + o1.w * o1.w);
                    if (HB) { u32x4 w; w.x = cvtpk(o0.x, o0.y); w.y = cvtpk(o0.z, o0.w); w.z = cvtpk(o1.x, o1.y); w.w = cvtpk(o1.z, o1.w); *(u32x4*)(HB + off + bj * HALF) = w; } }
                ss += __shfl_xor(ss, 16); ss += __shfl_xor(ss, 32);
                if (fq == 0) unsafeAtomicAdd(SS + row, ss); }
    }
};
struct EpiFF1 {
    static constexpr bool PERM = true, AFTER_DRAIN = false;
    const float* SS; bf16_t* AB;
    __device__ __forceinline__ void operator()(const f32x4 (&acc)[2][2][4][2], const Unit& u, int wr, int wc, int fr, int fq) const {
        const int row0 = u.pm * BM + wr * 64 + fr, col0 = u.pn * BM + wc * 32 + 8 * fq;
#pragma unroll
        for (int ai = 0; ai < 2; ++ai)
#pragma unroll
            for (int m = 0; m < 4; ++m) { const int row = row0 + ai * HALF + m * 16; const float rs = __builtin_amdgcn_rsqf(SS[row] * (1.0f / 1024.0f) + EPS);
#pragma unroll
                for (int bj = 0; bj < 2; ++bj) { float v[8];
#pragma unroll
                    for (int j = 0; j < 4; ++j) { v[j] = acc[ai][bj][m][0][j]; v[4 + j] = acc[ai][bj][m][1][j]; }
#pragma unroll
                    for (int j = 0; j < 8; ++j) { const float t = fmaxf(v[j] * rs, 0.f); v[j] = t * t; }
                    u32x4 w; w.x = cvtpk(v[0], v[1]); w.y = cvtpk(v[2], v[3]); w.z = cvtpk(v[4], v[5]); w.w = cvtpk(v[6], v[7]);
                    *(u32x4*)(AB + (size_t)row * FF + col0 + bj * HALF) = w; } }
    }
};
}

namespace sb {
__device__ __forceinline__ void unit(int b, int h, int qb, const bf16_t* Q, const bf16_t* __restrict__ K, const bf16_t* __restrict__ V, bf16_t* O, LAS unsigned char* lds) {
    const int tid = threadIdx.x, lane = tid & 63, r32 = lane & 31, hi = lane >> 5; const int wid = __builtin_amdgcn_readfirstlane(tid >> 6);
    const long rowbase = (long)b * SEQ; const int q0 = qb * 256, qw0 = q0 + wid * 32;
    const bf16_t* Qw = Q + (rowbase + qw0) * SBW + h * 64;
    bf16x8 qr[4];
#pragma unroll
    for (int d0 = 0; d0 < 4; ++d0) qr[d0] = *(const bf16x8*)(Qw + (long)r32 * SBW + d0 * 16 + hi * 8);
    bf16x8 tf0, tf1, ones;
#pragma unroll
    for (int j = 0; j < 8; ++j) { const int kk = 8 * (j >> 2) + 4 * hi + (j & 3); tf0[j] = (kk >= r32) ? (short)0x3F80 : (short)0; tf1[j] = (16 + kk >= r32) ? (short)0x3F80 : (short)0; ones[j] = (short)0x3F80; }
    f32x16 o0 = {}, o1 = {}; float carry = 0.f;
    const int NT = (q0 + 256) / 64;
    const bf16_t* kg = K + (rowbase + (tid & 63)) * SBW + h * 64 + (tid >> 6) * 8;
    const int kl = (tid >> 6) * 1024 + (tid & 63) * 16;
    const bf16_t* vg = V + (rowbase + 16 * (wid & 3) + (lane >> 2)) * SBW + h * 64 + (wid >> 2) * 32 + (lane & 3) * 8;
    const int vl = 16384 + wid * 1024 + lane * 16;
    const int vrd = 16384 + ((lane >> 4) & 1) * 32 + (lane & 3) * 8 + (4 * hi + ((lane & 15) >> 2)) * 64;
    u32x4 kreg = *(const u32x4*)(kg + (long)(NT - 1) * 64 * SBW), vreg = *(const u32x4*)(vg + (long)(NT - 1) * 64 * SBW);
    *(LAS u32x4*)(lds + kl) = kreg; *(LAS u32x4*)(lds + vl) = vreg;
    int it = 0;
    for (int t = NT - 1; t >= 0; --t, ++it) {
        const int bo = (it & 1) * 8192;
        __syncthreads();
        if (t > 0) { kreg = *(const u32x4*)(kg + (long)(t - 1) * 64 * SBW); vreg = *(const u32x4*)(vg + (long)(t - 1) * 64 * SBW); }
        const int k0 = 64 * t;
        if (k0 <= qw0 + 30) {
            f32x16 p0 = {}, p1 = {};
            const LAS unsigned char* kb = lds + bo + hi * 1024 + r32 * 16;
#pragma unroll
            for (int d0 = 0; d0 < 4; ++d0) { const bf16x8 a0 = *(const LAS bf16x8*)(kb + d0 * 2048), a1 = *(const LAS bf16x8*)(kb + d0 * 2048 + 512);
                p0 = MFMA32(a0, qr[d0], p0); p1 = MFMA32(a1, qr[d0], p1); }
            if (k0 + 63 >= qw0) { const int qpos = qw0 + r32;
#pragma unroll
                for (int r = 0; r < 16; ++r) { const int key = k0 + crow(r, hi); if (key >= qpos) p0[r] = -INFINITY; if (key + 32 >= qpos) p1[r] = -INFINITY; } }
            f32x16 l0, l1;
#pragma unroll
            for (int r = 0; r < 16; ++r) { l0[r] = -__builtin_amdgcn_logf(1.0f + __builtin_amdgcn_exp2f(p0[r])); l1[r] = -__builtin_amdgcn_logf(1.0f + __builtin_amdgcn_exp2f(p1[r])); }
            const bf16x8 lb0 = pack8(l0, 0), lb1 = pack8(l0, 1), lb2 = pack8(l1, 0), lb3 = pack8(l1, 1);
            f32x16 cv;
#pragma unroll
            for (int r = 0; r < 16; ++r) cv[r] = carry;
            f32x16 i1 = MFMA32(tf0, lb2, cv); i1 = MFMA32(tf1, lb3, i1);
            f32x16 i0 = MFMA32(ones, lb2, cv); i0 = MFMA32(ones, lb3, i0); i0 = MFMA32(tf0, lb0, i0); i0 = MFMA32(tf1, lb1, i0);
            carry = __shfl(i0[0], r32);
#pragma unroll
            for (int r = 0; r < 16; ++r) { p0[r] = __builtin_amdgcn_exp2f(p0[r] + i0[r]); p1[r] = __builtin_amdgcn_exp2f(p1[r] + i1[r]); }
            const bf16x8 pw0 = pack8(p0, 0), pw1 = pack8(p0, 1), pw2 = pack8(p1, 0), pw3 = pack8(p1, 1);
            const LAS unsigned char* vb = lds + vrd + bo;
            { const bf16x8 v0 = trfrag(vb), v1 = trfrag(vb + 1024), v2 = trfrag(vb + 2048), v3 = trfrag(vb + 3072);
              o0 = MFMA32(pw0, v0, o0); o0 = MFMA32(pw1, v1, o0); o0 = MFMA32(pw2, v2, o0); o0 = MFMA32(pw3, v3, o0); }
            { const bf16x8 v0 = trfrag(vb + 4096), v1 = trfrag(vb + 4096 + 1024), v2 = trfrag(vb + 4096 + 2048), v3 = trfrag(vb + 4096 + 3072);
              o1 = MFMA32(pw0, v0, o1); o1 = MFMA32(pw1, v1, o1); o1 = MFMA32(pw2, v2, o1); o1 = MFMA32(pw3, v3, o1); }
        }
        if (t > 0) { const int bn = ((it + 1) & 1) * 8192; *(LAS u32x4*)(lds + bn + kl) = kreg; *(LAS u32x4*)(lds + bn + vl) = vreg; }
    }
    { LAS bf16_t* stg = (LAS bf16_t*)(lds + 32768 + wid * 4096);
#pragma unroll
      for (int r = 0; r < 16; ++r) { const int orow = crow(r, hi); stg[orow * 64 + r32] = cvt1(o0[r]); stg[orow * 64 + 32 + r32] = cvt1(o1[r]); }
      asm volatile("s_waitcnt lgkmcnt(0)" ::: "memory");
      bf16_t* Ow = O + (rowbase + qw0) * SBW + h * 64;
#pragma unroll
      for (int i = 0; i < 4; ++i) { const int row = i * 8 + (lane >> 3), ch = lane & 7; const u32x4 v = *(const LAS u32x4*)(stg + row * 64 + ch * 8); *(u32x4*)(Ow + (long)row * SBW + ch * 8) = v; } }
    __syncthreads();
}
__device__ __forceinline__ void phase(int vcu, int G, const bf16_t* Q, const bf16_t* K, const bf16_t* V, bf16_t* O, LAS unsigned char* lds) {
    for (int p = vcu; p < 256; p += G) { const int bh = p >> 3, s = p & 7;
        unit(bh >> 3, bh & 7, 15 - s, Q, K, V, O, lds);
        unit(bh >> 3, bh & 7, s, Q, K, V, O, lds); }
}
}

namespace hg {
constexpr int IMG = 272;
__device__ __forceinline__ void b1_item(int bh, int c, const float* LF, const bf16_t* I, bf16_t* SL, float* DCH, LAS unsigned char* lds) {
    const int tid = threadIdx.x, lane = tid & 63, r32 = lane & 31, hi = lane >> 5; const int wid = __builtin_amdgcn_readfirstlane(tid >> 6);
    const int b = bh >> 2, h = bh & 3; const long rowc = (long)b * SEQ + c * 64;
    const int d = tid & 127, sc = tid >> 7;
    u32x4 vv[2];
#pragma unroll
    for (int i = 0; i < 2; ++i) { const int idx = tid + 512 * i, s = idx >> 4, ch = idx & 15; vv[i] = *(const u32x4*)(I + (rowc + s) * HGW + h * 128 + ch * 8); }
    float lf[16]; { const float* lp = LF + (rowc + 16 * sc) * HGW + h * 128 + d;
#pragma unroll
        for (int i = 0; i < 16; ++i) lf[i] = lp[(long)i * HGW]; }
    float bc[16]; float run = 0.f;
#pragma unroll
    for (int i = 0; i < 16; ++i) { run += lf[i]; bc[i] = run; }
    LAS float* TOT = (LAS float*)lds; TOT[sc * 128 + d] = run;
    LAS unsigned char* VIMG = lds + 2048; LAS unsigned char* KIMG = lds + 2048 + 16384;
#pragma unroll
    for (int i = 0; i < 2; ++i) { const int idx = tid + 512 * i, s = idx >> 4, e0 = (idx & 15) * 8; *(LAS u32x4*)(VIMG + (e0 >> 5) * 4096 + (s >> 4) * 1024 + (s & 15) * 64 + (e0 & 31) * 2) = vv[i]; }
    __syncthreads();
    const float t0 = TOT[d], t1 = TOT[128 + d], t2 = TOT[256 + d], t3 = TOT[384 + d];
    const float pre = (sc > 0 ? t0 : 0.f) + (sc > 1 ? t1 : 0.f) + (sc > 2 ? t2 : 0.f); const float blast = (t0 + t1) + (t2 + t3);
#pragma unroll
    for (int i = 0; i < 16; ++i) { const int s = 16 * sc + i; const float bcum = bc[i] + pre; const float k = 1.0f - fexp(lf[i]); const float kd = k * fexp(blast - bcum);
        *(LAS bf16_t*)(KIMG + (d >> 5) * 4096 + (s >> 4) * 1024 + (s & 15) * 64 + (d & 31) * 2) = cvt1(kd); }
    if (sc == 0) DCH[(size_t)(bh * 64 + c) * 128 + d] = fexp(blast);
    __syncthreads();
    const int eb = wid >> 1, dbp = (wid & 1) * 2;
    const int laneoff = ((lane >> 4) & 1) * 32 + (lane & 3) * 8 + (4 * hi + ((lane & 15) >> 2)) * 64;
    f32x16 a0 = {}, a1 = {};
#pragma unroll
    for (int ks = 0; ks < 4; ++ks) { const bf16x8 A = trfrag(VIMG + eb * 4096 + ks * 1024 + laneoff), B0 = trfrag(KIMG + dbp * 4096 + ks * 1024 + laneoff), B1 = trfrag(KIMG + (dbp + 1) * 4096 + ks * 1024 + laneoff);
        a0 = MFMA32(A, B0, a0); a1 = MFMA32(A, B1, a1); }
    bf16_t* out = SL + (size_t)(bh * 64 + c) * 16384;
#pragma unroll
    for (int r = 0; r < 16; ++r) { const int e = eb * 32 + crow(r, hi); out[e * 128 + dbp * 32 + r32] = cvt1(a0[r]); out[e * 128 + (dbp + 1) * 32 + r32] = cvt1(a1[r]); }
    __syncthreads();
}
__device__ __forceinline__ void b2_scan(int vcu, int G, bf16_t* SL, const float* DCH) {
    const int tid = threadIdx.x;
    for (int w = vcu; w < 128; w += G) { const int bh = w >> 3, part = w & 7; const int base = (part * 512 + tid) * 4, d = base & 127;
        float s0 = 0.f, s1 = 0.f, s2 = 0.f, s3 = 0.f;
        bf16_t* p = SL + (size_t)bh * 64 * 16384 + base; const float* dp = DCH + (size_t)bh * 64 * 128 + d;
        for (int c0 = 0; c0 < 64; c0 += 8) { u32x2 sv[8]; f32x4 dd[8];
#pragma unroll
            for (int j = 0; j < 8; ++j) { sv[j] = *(const u32x2*)(p + (size_t)(c0 + j) * 16384); dd[j] = *(const f32x4*)(dp + (c0 + j) * 128); }
#pragma unroll
            for (int j = 0; j < 8; ++j) { u32x2 w2; w2.x = cvtpk(s0, s1); w2.y = cvtpk(s2, s3); *(u32x2*)(p + (size_t)(c0 + j) * 16384) = w2;
                s0 = dd[j].x * s0 + __uint_as_float(sv[j].x << 16); s1 = dd[j].y * s1 + __uint_as_float(sv[j].x & 0xffff0000u); s2 = dd[j].z * s2 + __uint_as_float(sv[j].y << 16); s3 = dd[j].w * s3 + __uint_as_float(sv[j].y & 0xffff0000u); } }
    }
}
__device__ __forceinline__ void b3_item(int bh, int c, const float* LF, const bf16_t* QS, const bf16_t* I, const bf16_t* SG, const bf16_t* ST, const float* hgn, bf16_t* OHG, LAS unsigned char* lds) {
    const int tid = threadIdx.x, lane = tid & 63, r32 = lane & 31, hi = lane >> 5; const int wid = __builtin_amdgcn_readfirstlane(tid >> 6);
    const int b = bh >> 2, h = bh & 3; const long rowc = (long)b * SEQ + c * 64;
    const int d = tid & 127, sc = tid >> 7; const int tm = wid >> 2, en = wid & 3;
    bf16x8 sf[8]; { const bf16_t* sp = ST + (size_t)(bh * 64 + c) * 16384 + (en * 32 + r32) * 128 + hi * 8;
#pragma unroll
        for (int ks = 0; ks < 8; ++ks) sf[ks] = *(const bf16x8*)(sp + ks * 16); }
    u32x4 vv[2];
#pragma unroll
    for (int i = 0; i < 2; ++i) { const int idx = tid + 512 * i, s = idx >> 4, ch = idx & 15; vv[i] = *(const u32x4*)(I + (rowc + s) * HGW + h * 128 + ch * 8); }
    float lf[16]; float qv[16]; { const float* lp = LF + (rowc + 16 * sc) * HGW + h * 128 + d; const bf16_t* qp = QS + (rowc + 16 * sc) * HGW + h * 128 + d;
#pragma unroll
        for (int i = 0; i < 16; ++i) { lf[i] = lp[(long)i * HGW]; qv[i] = bf2f(qp[(long)i * HGW]); } }
    float bc[16]; float run = 0.f;
#pragma unroll
    for (int i = 0; i < 16; ++i) { run += lf[i]; bc[i] = run; }
    LAS float* TOT = (LAS float*)lds; TOT[sc * 128 + d] = run;
    LAS unsigned char* QT = lds + 2048; LAS unsigned char* QA = lds + 19456; LAS unsigned char* K1 = lds + 36864; LAS unsigned char* K0 = lds + 54272; LAS unsigned char* VIMG = lds + 62976;
#pragma unroll
    for (int i = 0; i < 2; ++i) { const int idx = tid + 512 * i, s = idx >> 4, e0 = (idx & 15) * 8; *(LAS u32x4*)(VIMG + (e0 >> 5) * 4096 + (s >> 4) * 1024 + (s & 15) * 64 + (e0 & 31) * 2) = vv[i]; }
    __syncthreads();
    { const float t0 = TOT[d], t1 = TOT[128 + d], t2 = TOT[256 + d];
      const float pre = (sc > 0 ? t0 : 0.f) + (sc > 1 ? t1 : 0.f) + (sc > 2 ? t2 : 0.f); const float ref1 = t0 + t1; const float ref = (sc >= 2) ? ref1 : 0.f;
#pragma unroll
      for (int i = 0; i < 16; ++i) { const int s = 16 * sc + i; const float bcum = bc[i] + pre; const float k = 1.0f - fexp(lf[i]); const int off = s * IMG + d * 2;
          *(LAS bf16_t*)(QA + off) = cvt1(qv[i] * fexp(bcum));
          *(LAS bf16_t*)(QT + off) = cvt1(qv[i] * fexp(bcum - ref));
          *(LAS bf16_t*)(K1 + off) = cvt1(k * fexp(fminf(ref1 - bcum, 80.f)));
          if (sc < 2) *(LAS bf16_t*)(K0 + off) = cvt1(k * fexp(fminf(-bcum, 80.f))); } }
    __syncthreads();
    f32x16 o = {};
    { const LAS unsigned char* ap = QA + (32 * tm + r32) * IMG + hi * 16;
#pragma unroll
      for (int ks = 0; ks < 8; ++ks) o = MFMA32(*(const LAS bf16x8*)(ap + ks * 32), sf[ks], o); }
    const int laneoff = ((lane >> 4) & 1) * 32 + (lane & 3) * 8 + (4 * hi + ((lane & 15) >> 2)) * 64;
    const LAS unsigned char* kimg = tm ? K1 : K0;
    const LAS unsigned char* qp2 = QT + (32 * tm + r32) * IMG + hi * 16;
    for (int sh = 0; sh <= tm; ++sh) {
        f32x16 s_ = {};
        const LAS unsigned char* kp = kimg + (32 * sh + r32) * IMG + hi * 16;
#pragma unroll
        for (int ks = 0; ks < 8; ++ks) s_ = MFMA32(*(const LAS bf16x8*)(kp + ks * 32), *(const LAS bf16x8*)(qp2 + ks * 32), s_);
        if (sh == tm) {
#pragma unroll
            for (int r = 0; r < 16; ++r) if (crow(r, hi) > r32) s_[r] = 0.f; }
        const bf16x8 pa = pack8(s_, 0), pb = pack8(s_, 1);
        const bf16x8 vf0 = trfrag(VIMG + en * 4096 + (2 * sh) * 1024 + laneoff), vf1 = trfrag(VIMG + en * 4096 + (2 * sh + 1) * 1024 + laneoff);
        o = MFMA32(pa, vf0, o); o = MFMA32(pb, vf1, o);
    }
    __syncthreads();
    LAS float* OS = (LAS float*)(lds + 2048);
#pragma unroll
    for (int r = 0; r < 16; ++r) OS[(32 * tm + crow(r, hi)) * 132 + en * 32 + r32] = o[r];
    __syncthreads();
    { const int t = tid >> 3, j = tid & 7; float v[16]; float ss = 0.f;
#pragma unroll
      for (int q = 0; q < 4; ++q) { const f32x4 x = *(const LAS f32x4*)(OS + t * 132 + j * 16 + q * 4); v[4 * q] = x.x; v[4 * q + 1] = x.y; v[4 * q + 2] = x.z; v[4 * q + 3] = x.w; ss += (x.x * x.x + x.y * x.y) + (x.z * x.z + x.w * x.w); }
      ss += __shfl_xor(ss, 1); ss += __shfl_xor(ss, 2); ss += __shfl_xor(ss, 4);
      const float rs = __builtin_amdgcn_rsqf(ss * (1.0f / 128.0f) + EPS);
      const size_t go = (size_t)(rowc + t) * HGW + h * 128 + j * 16; const float* gp = hgn + h * 128 + j * 16;
      const u32x4 g0 = *(const u32x4*)(SG + go), g1 = *(const u32x4*)(SG + go + 8);
      const unsigned gw[8] = {g0.x, g0.y, g0.z, g0.w, g1.x, g1.y, g1.z, g1.w}; unsigned ow[8];
#pragma unroll
      for (int q = 0; q < 8; ++q) { const float y0 = v[2 * q] * rs * gp[2 * q] * __uint_as_float(gw[q] << 16), y1 = v[2 * q + 1] * rs * gp[2 * q + 1] * __uint_as_float(gw[q] & 0xffff0000u); ow[q] = cvtpk(y0, y1); }
      *(u32x4*)(OHG + go) = (u32x4){ow[0], ow[1], ow[2], ow[3]}; *(u32x4*)(OHG + go + 8) = (u32x4){ow[4], ow[5], ow[6], ow[7]}; }
    __syncthreads();
}
}


#define XB_TMO      128
#define XB_XCNT(j)  (256  + 64 * (j))
#define XB_XSUB(j)  (1280 + 64 * (j))
#define XB_XGEN(j)  (2304 + 64 * (j))
#define XB_TOP      3328
#define XB_TOPGEN   3392
#define XCD_BAR_WORDS 3456
#define XB_SPIN_CAP (1u << 18)

__device__ __forceinline__ unsigned xb_ld(unsigned* p)              { return __hip_atomic_load(p, __ATOMIC_RELAXED, __HIP_MEMORY_SCOPE_AGENT); }
__device__ __forceinline__ unsigned xb_add(unsigned* p, unsigned v) { return __hip_atomic_fetch_add(p, v, __ATOMIC_RELAXED, __HIP_MEMORY_SCOPE_AGENT); }
__device__ __forceinline__ unsigned xb_xcc_id() { return (unsigned)__builtin_amdgcn_s_getreg((3 << 11) | 20) & 0xFu; }
#define XB_SPIN(cond, bar) do { unsigned _sp = 0; while (cond) { __builtin_amdgcn_s_sleep(1); \
    if ((++_sp & 255u) == 0u) { if (xb_ld(&(bar)[XB_TMO])) break; if (_sp > XB_SPIN_CAP) { atomicAdd(&(bar)[XB_TMO], 1u); break; } } } } while (0)

struct XcdBarrier {
    unsigned* bar; unsigned x;
    volatile LAS unsigned* st;
};

__device__ __forceinline__ XcdBarrier xcd_barrier_post(unsigned* bar, volatile LAS unsigned* st) {
    XcdBarrier b; b.bar = bar; b.x = xb_xcc_id(); b.st = st;
    if (threadIdx.x == 0) (void)xb_add(&bar[XB_XCNT(b.x)], 1u);
    return b;
}
__device__ __forceinline__ void xcd_barrier_complete(unsigned* bar, unsigned x, unsigned& nloc, unsigned& nx) {
    const unsigned G = gridDim.x * gridDim.y * gridDim.z;
    unsigned sum, cnt, mine, sp = 0u;
    for (;;) {
        sum = 0u; cnt = 0u; mine = 0u;
#pragma unroll
        for (unsigned j = 0; j < 16; ++j) { const unsigned c = xb_ld(&bar[XB_XCNT(j)]); sum += c; cnt += (c > 0u) ? 1u : 0u; mine = (j == x) ? c : mine; }
        if (sum == G) break;
        __builtin_amdgcn_s_sleep(1);
        if ((++sp & 255u) == 0u) { if (xb_ld(&bar[XB_TMO])) break; if (sp > XB_SPIN_CAP) { atomicAdd(&bar[XB_TMO], 1u); break; } }
    }
    nloc = mine > 0u ? mine : 1u; nx = cnt > 0u ? cnt : 1u;
}

__device__ __forceinline__ void xcd_barrier(const XcdBarrier& b) {
    asm volatile("s_waitcnt vmcnt(0)" ::: "memory");
    __syncthreads();
    if (threadIdx.x == 0) {
        unsigned* bar = b.bar;
        __builtin_amdgcn_s_waitcnt(0);
        unsigned nloc = b.st[0], nx = b.st[1];
        if (nloc == 0u) { xcd_barrier_complete(bar, b.x, nloc, nx); b.st[0] = nloc; b.st[1] = nx; }
        const unsigned old = xb_add(&bar[XB_XSUB(b.x)], 1u);
        const unsigned gen = old / nloc;
        if (old + 1u == (gen + 1u) * nloc) {
            __builtin_amdgcn_fence(__ATOMIC_RELEASE, "agent");
            asm volatile("s_waitcnt vmcnt(0)" ::: "memory");
            const unsigned og = xb_add(&bar[XB_TOP], 1u);
            const unsigned tg = og / nx;
            if (og + 1u == (tg + 1u) * nx) xb_add(&bar[XB_TOPGEN], 1u);
            else XB_SPIN(xb_ld(&bar[XB_TOPGEN]) == tg, bar);
            __builtin_amdgcn_fence(__ATOMIC_ACQUIRE, "agent");
            xb_add(&bar[XB_XGEN(b.x)], 1u);
            asm volatile("s_waitcnt vmcnt(0)" ::: "memory");
        } else {
            XB_SPIN(xb_ld(&bar[XB_XGEN(b.x)]) == gen, bar);
            __builtin_amdgcn_fence(__ATOMIC_ACQUIRE, "agent");
            asm volatile("s_waitcnt vmcnt(0)" ::: "memory");
        }
    }
    __syncthreads();
}

constexpr int NWAVES = 8;
#ifndef PROBE_MODE
#define PROBE_MODE 0
#endif
#ifndef MK_PER_PHASE
#define MK_PER_PHASE 0
#endif
constexpr int N_PHASES = 10;
constexpr size_t MiB = 1u << 20;
constexpr size_t WS_SS1 = 0, WS_SS2 = 65536, WS_BAR = 131072, WS_BAR_BYTES = 16384, WS_DCH = 262144;
constexpr size_t WS_WIN = 1 * MiB, WS_WOSB = 12 * MiB, WS_WOHG = 13 * MiB, WS_WOUT = 14 * MiB, WS_WFF1 = 16 * MiB, WS_WFF2 = 24 * MiB;
constexpr size_t WS_XN = 32 * MiB;
constexpr size_t WS_Q = 64 * MiB, WS_K = 80 * MiB, WS_V = 96 * MiB;
constexpr size_t WS_LF = 112 * MiB;
constexpr size_t WS_I = 144 * MiB, WS_QS = 160 * MiB, WS_SG = 176 * MiB, WS_OHG = 192 * MiB;
constexpr size_t WS_HB = 208 * MiB;
constexpr size_t WS_TMP = 112 * MiB;
constexpr size_t WS_AB = 64 * MiB;
constexpr size_t WS_END = 240 * MiB;
constexpr int RING_BYTES = 131072, LDS_BYTES = 147456;

__device__ __forceinline__ float wave_sum(float v) {
#pragma unroll
    for (int o = 1; o < 64; o <<= 1) v += __shfl_xor(v, o);
    return v;
}
__device__ __forceinline__ void p0_transpose_item(const float* W, int K, int N, bf16_t* WT, const float* kscale, LAS float* scr, int item, int lane) {
    const int nblk = N / 32, kb = item / nblk, nb = item % nblk, k0 = 64 * kb, n0 = 32 * nb;
#pragma unroll 8
    for (int i = 0; i < 32; ++i) { const int kk = 2 * i + (lane >> 5); float w = W[(size_t)(k0 + kk) * N + n0 + (lane & 31)]; if (kscale) w *= kscale[k0 + kk]; scr[kk * 33 + (lane & 31)] = w; }
    asm volatile("s_waitcnt lgkmcnt(0)" ::: "memory");
    const int c = lane & 7;
#pragma unroll
    for (int j = 0; j < 4; ++j) { const int n = (lane >> 3) + 8 * j; const LAS float* s = scr + (8 * c) * 33 + n;
        u32x4 o; o.x = cvtpk(s[0 * 33], s[1 * 33]); o.y = cvtpk(s[2 * 33], s[3 * 33]); o.z = cvtpk(s[4 * 33], s[5 * 33]); o.w = cvtpk(s[6 * 33], s[7 * 33]);
        *(u32x4*)(WT + (size_t)(n0 + n) * K + k0 + 8 * c) = o; }
    asm volatile("s_waitcnt lgkmcnt(0)" ::: "memory");
}

struct Args { const float* in[13]; float* out; unsigned char* ws; int ph_lo, ph_hi; };
__global__ void __launch_bounds__(NWAVES * 64, 2) fwd_kernel(Args args) {
    extern __shared__ __attribute__((aligned(16))) unsigned char lds_raw[];
    LAS unsigned char* lds = (LAS unsigned char*)lds_raw;
    const int tid = threadIdx.x, lane = tid & 63, wave = __builtin_amdgcn_readfirstlane(tid >> 6);
    const int G = gridDim.x; const int bx = blockIdx.x; const int vcu = (G % 8 == 0) ? (bx % 8) * (G / 8) + bx / 8 : bx;
    unsigned char* ws = args.ws;
    const float* x = args.in[0]; const float* norm1_g = args.in[1]; const float* w_in = args.in[2]; const float* b_gate = args.in[3]; const float* lb_logits = args.in[4];
    const float* hg_norm_g = args.in[5]; const float* w_o_sb = args.in[6]; const float* w_o_hg = args.in[7]; const float* w_out = args.in[8]; const float* norm2_g = args.in[9];
    const float* w_ff1 = args.in[10]; const float* w_ff2 = args.in[11]; const float* final_g = args.in[12];
    float* out = args.out;
    float* SS1 = (float*)(ws + WS_SS1); float* SS2 = (float*)(ws + WS_SS2); float* DCH = (float*)(ws + WS_DCH);
    bf16_t* WIN = (bf16_t*)(ws + WS_WIN); bf16_t* WOSB = (bf16_t*)(ws + WS_WOSB); bf16_t* WOHG = (bf16_t*)(ws + WS_WOHG); bf16_t* WOUT = (bf16_t*)(ws + WS_WOUT);
    bf16_t* WFF1 = (bf16_t*)(ws + WS_WFF1); bf16_t* WFF2 = (bf16_t*)(ws + WS_WFF2);
    bf16_t* XN = (bf16_t*)(ws + WS_XN); bf16_t* SL = XN; bf16_t* MG = XN;
    bf16_t* QB = (bf16_t*)(ws + WS_Q); bf16_t* KB = (bf16_t*)(ws + WS_K); bf16_t* VB = (bf16_t*)(ws + WS_V); float* LF = (float*)(ws + WS_LF);
    bf16_t* IB = (bf16_t*)(ws + WS_I); bf16_t* QS = (bf16_t*)(ws + WS_QS); bf16_t* SG = (bf16_t*)(ws + WS_SG); bf16_t* OHG = (bf16_t*)(ws + WS_OHG);
    bf16_t* HB = (bf16_t*)(ws + WS_HB); float* TMP = (float*)(ws + WS_TMP); bf16_t* AB = (bf16_t*)(ws + WS_AB);
    bf16_t* GA = (bf16_t*)out; bf16_t* GB = GA + (size_t)M * 1024;
    const int lo = args.ph_lo, hi = args.ph_hi;
    volatile LAS unsigned* bst = (volatile LAS unsigned*)(lds + RING_BYTES + 64);
    if (tid < 2) bst[tid] = 0u;
    __syncthreads();
    XcdBarrier bar = xcd_barrier_post((unsigned*)(ws + WS_BAR), bst);
    if (lo < 0) cg::this_grid().sync();
#define IN(k) (lo <= (k) && (k) < hi)
#define SEAM(k) do { if (IN(k) && IN((k) + 1)) { xcd_barrier(bar); if (PROBE_MODE == 3) xcd_barrier(bar); } } while (0)

    if (IN(0)) {
        LAS float* scr = (LAS float*)(lds + wave * 16384);
        const int gw = vcu * NWAVES + wave, NGW = G * NWAVES;
        constexpr int I_IN = (DM / 64) * (NIN / 32), I_OS = (512 / 64) * (DM / 32), I_OUT = (DM / 64) * (DM / 32), I_F1 = (DM / 64) * (FF / 32), I_F2 = (FF / 64) * (DM / 32);
        constexpr int NITEMS = I_IN + 2 * I_OS + I_OUT + I_F1 + I_F2;
        for (int it = gw; it < NITEMS; it += NGW) { int r = it;
            if (r < I_IN) { p0_transpose_item(w_in, DM, NIN, WIN, nullptr, scr, r, lane); continue; } r -= I_IN;
            if (r < I_OS) { p0_transpose_item(w_o_sb, 512, DM, WOSB, nullptr, scr, r, lane); continue; } r -= I_OS;
            if (r < I_OS) { p0_transpose_item(w_o_hg, 512, DM, WOHG, nullptr, scr, r, lane); continue; } r -= I_OS;
            if (r < I_OUT) { p0_transpose_item(w_out, DM, DM, WOUT, nullptr, scr, r, lane); continue; } r -= I_OUT;
            if (r < I_F1) { p0_transpose_item(w_ff1, DM, FF, WFF1, norm2_g, scr, r, lane); continue; } r -= I_F1;
            p0_transpose_item(w_ff2, FF, DM, WFF2, nullptr, scr, r, lane); }
        for (int m = gw; m < M; m += NGW) { const f32x4* xr = (const f32x4*)(x + (size_t)m * DM) + lane; f32x4 v[4]; float s = 0.f;
#pragma unroll
            for (int j = 0; j < 4; ++j) { v[j] = xr[64 * j]; s += (v[j].x * v[j].x + v[j].y * v[j].y) + (v[j].z * v[j].z + v[j].w * v[j].w); }
            const float rs = __builtin_amdgcn_rsqf(wave_sum(s) * (1.0f / DM) + EPS);
            u32x2* o8 = (u32x2*)(XN + (size_t)m * DM) + lane;
#pragma unroll
            for (int j = 0; j < 4; ++j) { const f32x4 g = ((const f32x4*)norm1_g)[lane + 64 * j]; u32x2 w; w.x = cvtpk(v[j].x * rs * g.x, v[j].y * rs * g.y); w.y = cvtpk(v[j].z * rs * g.z, v[j].w * rs * g.w); o8[64 * j] = w; } }
        for (int i = bx * 512 + tid; i < 2 * M; i += G * 512) { if (i < M) SS1[i] = 0.f; else SS2[i - M] = 0.f; }
    }
    SEAM(0);
    if (IN(1)) { pg8::Gemm g{XN, WIN, M, NIN, DM}; pg8::StaticOrder S; S.init(M, NIN, G, bx);
        pg8::EpiIn E{QB, KB, VB, IB, QS, SG, GA, GB, LF, lb_logits, b_gate};
        pg8::gemm_phase<pg8::EpiIn, pg8::StaticOrder, true, true>(lds, g, S, E); if (PROBE_MODE == 4) pg8::gemm_phase<pg8::EpiIn, pg8::StaticOrder, true, true>(lds, g, S, E); }
    SEAM(1);
    if (IN(2)) { for (int rep = 0; rep < (PROBE_MODE == 2 ? 2 : 1); ++rep) for (int it = vcu; it < 1024; it += G) hg::b1_item(it >> 6, it & 63, LF, IB, SL, DCH, lds); }
    SEAM(2);
    if (IN(3)) { hg::b2_scan(vcu, G, SL, DCH); if (PROBE_MODE == 1) sb::phase(vcu, G, QB, KB, VB, HB, lds); sb::phase(vcu, G, QB, KB, VB, QB, lds); }
    SEAM(3);
    if (IN(4)) { for (int rep = 0; rep < (PROBE_MODE == 2 ? 2 : 1); ++rep) for (int it = vcu; it < 1024; it += G) hg::b3_item(it >> 6, it & 63, LF, QS, IB, SG, SL, hg_norm_g, OHG, lds); }
    SEAM(4);
    if (IN(5)) for (int rep = 0; rep < (PROBE_MODE == 4 ? 2 : 1); ++rep) {
        { pg8::Gemm g{QB, WOSB, M, DM, 512}; pg8::StaticOrder S; S.init(M, DM, G, bx); pg8::EpiM1 E{GA, TMP}; pg8::gemm_phase<pg8::EpiM1, pg8::StaticOrder, true, true>(lds, g, S, E); }
        { pg8::Gemm g{OHG, WOHG, M, DM, 512}; pg8::StaticOrder S; S.init(M, DM, G, bx); pg8::EpiM2 E{GB, TMP, MG}; pg8::gemm_phase<pg8::EpiM2, pg8::StaticOrder, true, true>(lds, g, S, E); }
    }
    SEAM(5);
    if (IN(6)) { pg8::Gemm g{MG, WOUT, M, DM, DM}; pg8::StaticOrder S; S.init(M, DM, G, bx); pg8::EpiRes E{x, out, HB, SS1}; pg8::gemm_phase<pg8::EpiRes, pg8::StaticOrder, true, true>(lds, g, S, E); }
    SEAM(6);
    if (IN(7)) { pg8::Gemm g{HB, WFF1, M, FF, DM}; pg8::StaticOrder S; S.init(M, FF, G, bx); pg8::EpiFF1 E{SS1, AB}; pg8::gemm_phase<pg8::EpiFF1, pg8::StaticOrder, true, true>(lds, g, S, E); if (PROBE_MODE == 4) pg8::gemm_phase<pg8::EpiFF1, pg8::StaticOrder, true, true>(lds, g, S, E); }
    SEAM(7);
    if (IN(8)) { pg8::Gemm g{AB, WFF2, M, DM, FF}; pg8::StaticOrder S; S.init(M, DM, G, bx); pg8::EpiRes E{out, out, nullptr, SS2}; pg8::gemm_phase<pg8::EpiRes, pg8::StaticOrder, true, true>(lds, g, S, E); }
    SEAM(8);
    if (IN(9)) { const int gw = vcu * NWAVES + wave, NGW = G * NWAVES;
        for (int m = gw; m < M; m += NGW) { f32x4* xr = (f32x4*)(out + (size_t)m * DM) + lane; const float rs = __builtin_amdgcn_rsqf(SS2[m] * (1.0f / DM) + EPS);
#pragma unroll
            for (int j = 0; j < 4; ++j) { const f32x4 g = ((const f32x4*)final_g)[lane + 64 * j]; f32x4 v = xr[64 * j]; v.x *= rs * g.x; v.y *= rs * g.y; v.z *= rs * g.z; v.w *= rs * g.w; xr[64 * j] = v; } } }
#undef IN
#undef SEAM
}

extern "C" void kernel_launch(void* const* d_in, const int* in_sizes, int n_in, void* d_out, int out_size, void* d_ws, size_t ws_size, hipStream_t stream) {
    static int grid = 0;
    if (grid == 0) {
        if (n_in != 13 || out_size != M * DM || ws_size < WS_END) { fprintf(stderr, "kernel_launch: unexpected problem (n_in %d out %d ws %zu)\n", n_in, out_size, ws_size); grid = -1; return; }
        int dev = 0, cus = 0, per_cu = 0;
        if (hipGetDevice(&dev) != hipSuccess || hipDeviceGetAttribute(&cus, hipDeviceAttributeMultiprocessorCount, dev) != hipSuccess) { grid = -1; return; }
        if (hipFuncSetAttribute((const void*)fwd_kernel, hipFuncAttributeMaxDynamicSharedMemorySize, LDS_BYTES) != hipSuccess) { fprintf(stderr, "kernel_launch: hipFuncSetAttribute failed\n"); grid = -1; return; }
        if (hipOccupancyMaxActiveBlocksPerMultiprocessor(&per_cu, (const void*)fwd_kernel, NWAVES * 64, LDS_BYTES) != hipSuccess || per_cu < 1) { fprintf(stderr, "kernel_launch: occupancy query says %d\n", per_cu); per_cu = 1; }
        (void)hipGetLastError();
        grid = cus;
    }
    if (grid < 0) return;
    if (hipMemsetAsync((char*)d_ws + WS_BAR, 0, WS_BAR_BYTES, stream) != hipSuccess) { fprintf(stderr, "kernel_launch: memset of the barrier words failed\n"); return; }
    Args a{};
    for (int i = 0; i < 13; ++i) a.in[i] = (const float*)d_in[i];
    a.out = (float*)d_out; a.ws = (unsigned char*)d_ws;
#if MK_PER_PHASE
    for (int p = 0; p < N_PHASES; ++p) { a.ph_lo = p; a.ph_hi = p + 1; hipLaunchKernelGGL(fwd_kernel, dim3(grid), dim3(NWAVES * 64), LDS_BYTES, stream, a); }
#else
    a.ph_lo = 0; a.ph_hi = N_PHASES;
    void* kargs[] = {&a};
    const hipError_t e = hipLaunchCooperativeKernel((const void*)fwd_kernel, dim3(grid), dim3(NWAVES * 64), kargs, LDS_BYTES, stream);
    if (e != hipSuccess) fprintf(stderr, "kernel_launch: cooperative launch failed: %s (grid %d)\n", hipGetErrorString(e), grid);
#endif
}
```

```cpp
#include <hip/hip_runtime.h>
#include <hip/hip_cooperative_groups.h>
#include <cstdio>
#include <cstdint>
#include <cmath>
namespace cg = cooperative_groups;
namespace pg8 {
#define PG8_LAS __attribute__((address_space(3)))
typedef unsigned short bf16_t;
typedef short bf16x8 __attribute__((ext_vector_type(8)));
typedef float f32x4 __attribute__((ext_vector_type(4)));
typedef unsigned u32x4 __attribute__((ext_vector_type(4)));
constexpr int BM = 256, BK = 64, HALF = 128, HTB = HALF * BK * 2  , STAGE_BYTES = 8 * HTB, NXCD = 8, WGM = 8;

__host__ __device__ __forceinline__ int lds_byte(int r, int c) { const int st = (r >> 4) * 2 + (c >> 5), rr = r & 15, cc = c & 31, ob = rr * 64 + cc * 2; return st * 1024 + (ob ^ (((ob >> 9) & 1) << 5)); }
__host__ __device__ __forceinline__ void stage_rc(int b, int& R, int& C) { const int st = b / 1024, sb = b % 1024, swz = sb ^ (((sb >> 9) & 1) << 5); R = (st >> 1) * 16 + swz / 64; C = (st & 1) * 32 + (swz % 64) / 2; }
__host__ __device__ __forceinline__ int perm32(int rho) { const int n = rho >> 4, i = rho & 15; return 8 * (i >> 2) + 4 * n + (i & 3); }

struct Unit { int pm, pn; };
struct Gemm { const bf16_t* A; const bf16_t* Bt; int M, N, K; };

struct StaticOrder {
    int nM, nN, nwg, G, c;
    __host__ __device__ void init(int M, int N, int G_, int c_) { nM = M / BM; nN = N / BM; nwg = nM * nN; G = G_; c = c_; }
    __host__ __device__ bool next(int i, Unit& u) const {
        const long L = (long)i * G + c; if (L >= nwg) return false;
        int wgid = (int)L; { const int q = nwg / NXCD, r = nwg % NXCD, xcd = wgid % NXCD, off = wgid / NXCD; wgid = (xcd < r ? xcd * (q + 1) : r * (q + 1) + (xcd - r) * q) + off; }
        const int nig = WGM * nN, gid = wgid / nig, fm = gid * WGM, gsz = (nM - fm) < WGM ? (nM - fm) : WGM;
        u.pm = fm + ((wgid % nig) % gsz); u.pn = (wgid % nig) / gsz; return true;
    }
    __device__ __forceinline__ void a_ready(const Unit&) const {}
    __device__ __forceinline__ void done(const Unit&) const {}
};

__device__ __forceinline__ unsigned cvt_pk_bf16(float lo, float hi) { unsigned r; asm volatile("v_cvt_pk_bf16_f32 %0, %1, %2" : "=v"(r) : "v"(lo), "v"(hi)); return r; }
typedef float f32x2 __attribute__((ext_vector_type(2)));
template <class Epi, class Sched, bool ALIGN_EPI = false, bool SP2 = false, int MIDT = 0>
__device__ __forceinline__ void gemm_phase(PG8_LAS unsigned char* lds, const Gemm g, const Sched& S, const Epi& E) {
    const int tid = threadIdx.x, wid = __builtin_amdgcn_readfirstlane(tid >> 6), lane = tid & 63, wr = wid >> 2, wc = wid & 3, fr = lane & 15, fq = lane >> 4;
    const int K = g.K, nt = K / BK;
    unsigned voffA[2], voffB[2];
#pragma unroll
    for (int i = 0; i < 2; ++i) { int R, C; stage_rc(tid * 16 + i * 8192, R, C); const int Rb = Epi::PERM ? ((R & ~31) + perm32(R & 31)) : R;
        voffA[i] = (unsigned)(R * K + C) * 2u; voffB[i] = (unsigned)(Rb * K + C) * 2u; }
    const size_t kstep = (size_t)(BK * 2);
    const size_t hstep = (size_t)HALF * K * 2;
    const size_t tstep = 2 * hstep;
    const unsigned ldsw = (unsigned)wid * 1024u;
    const int aoff = lds_byte(wr * 64 + fr, fq * 8), boff = lds_byte(wc * 32 + fr, fq * 8);
#define PG8_SA(b, h) (((b) * 2 + (h)) * HTB)
#define PG8_SB(b, h) ((4 + (b) * 2 + (h)) * HTB)
#define PG8_STAGE(bufoff, gbase, voff) do { _Pragma("unroll") for (int _i = 0; _i < 2; ++_i) \
        __builtin_amdgcn_global_load_lds((const unsigned*)((const char*)(gbase) + (voff)[_i]), (PG8_LAS unsigned*)(lds + (bufoff) + ldsw + _i * 8192), 16, 0, 0); } while (0)
#define PG8_LDA(dst, b, h) do { _Pragma("unroll") for (int m = 0; m < 4; ++m) _Pragma("unroll") for (int k = 0; k < 2; ++k) dst[m][k] = *(const PG8_LAS bf16x8*)(lds + PG8_SA(b, h) + aoff + m * 2048 + k * 1024); } while (0)
#define PG8_LDB(dst, b, h) do { _Pragma("unroll") for (int n = 0; n < 2; ++n) _Pragma("unroll") for (int k = 0; k < 2; ++k) dst[n][k] = *(const PG8_LAS bf16x8*)(lds + PG8_SB(b, h) + boff + n * 2048 + k * 1024); } while (0)
#define PG8_MMA(ai, bj, At, Bt) do { __builtin_amdgcn_s_setprio(1); _Pragma("unroll") for (int m = 0; m < 4; ++m) _Pragma("unroll") for (int n = 0; n < 2; ++n) _Pragma("unroll") for (int k = 0; k < 2; ++k) \
        acc[ai][bj][m][n] = __builtin_amdgcn_mfma_f32_16x16x32_bf16(Bt[n][k], At[m][k], acc[ai][bj][m][n], 0, 0, 0); __builtin_amdgcn_s_setprio(0); } while (0)
#define PG8_WAIT_V(n) asm volatile("s_waitcnt vmcnt(" #n ")" ::: "memory")
#define PG8_WAIT_L(n) asm volatile("s_waitcnt lgkmcnt(" #n ")" ::: "memory")
#define PG8_BAR __builtin_amdgcn_s_barrier()
#define PG8_SCHED __builtin_amdgcn_sched_barrier(0)
    Unit cur, nxt; int ui = 0;
    if (!S.next(0, cur)) return;
    f32x4 acc[2][2][4][2];
#pragma unroll
    for (int a = 0; a < 2; ++a)
#pragma unroll
        for (int b = 0; b < 2; ++b)
#pragma unroll
            for (int m = 0; m < 4; ++m)
#pragma unroll
                for (int n = 0; n < 2; ++n) acc[a][b][m][n] = (f32x4){0.f, 0.f, 0.f, 0.f};
    bf16x8 At[4][2], B0[2][2], B1[2][2];
    const char* cA = (const char*)g.A + (size_t)cur.pm * tstep; const char* cB = (const char*)g.Bt + (size_t)cur.pn * tstep;
    S.a_ready(cur);
    if constexpr (SP2) {
        PG8_STAGE(PG8_SB(0, 0), cB, voffB); PG8_STAGE(PG8_SB(0, 1), cB + hstep, voffB); PG8_STAGE(PG8_SA(0, 0), cA, voffA); PG8_STAGE(PG8_SA(0, 1), cA + hstep, voffA);
        if (wr == 1) PG8_BAR;
        PG8_WAIT_V(2); PG8_BAR;
        PG8_STAGE(PG8_SB(1, 0), cB + kstep, voffB); PG8_STAGE(PG8_SA(1, 0), cA + kstep, voffA); PG8_STAGE(PG8_SB(1, 1), cB + hstep + kstep, voffB);
        PG8_WAIT_V(6); PG8_BAR;
    } else {
        PG8_STAGE(PG8_SB(0, 0), cB, voffB); PG8_STAGE(PG8_SA(0, 0), cA, voffA); PG8_STAGE(PG8_SB(0, 1), cB + hstep, voffB); PG8_STAGE(PG8_SA(0, 1), cA + hstep, voffA);
        if (wr == 1) PG8_BAR;
        PG8_WAIT_V(4); PG8_BAR;
        PG8_STAGE(PG8_SB(1, 0), cB + kstep, voffB); PG8_STAGE(PG8_SA(1, 0), cA + kstep, voffA); PG8_STAGE(PG8_SB(1, 1), cB + hstep + kstep, voffB);
        PG8_WAIT_V(6); PG8_BAR;
    }
    for (;;) {
        const bool has_next = S.next(ui + 1, nxt);
        const char* nA = has_next ? (const char*)g.A + (size_t)nxt.pm * tstep : cA; const char* nB = has_next ? (const char*)g.Bt + (size_t)nxt.pn * tstep : cB;
        for (int t = 0; t < nt; t += 2) {
            const bool last = (t == nt - 2);
            const char* a1 = cA + (size_t)(t + 1) * kstep;
            const char* a2 = last ? nA : cA + (size_t)(t + 2) * kstep; const char* b2 = last ? nB : cB + (size_t)(t + 2) * kstep;
            const char* a3 = a2 + kstep; const char* b3 = b2 + kstep;
            if (last && has_next) S.a_ready(nxt);
            if constexpr (SP2) {
            PG8_LDB(B0, 0, 0); PG8_LDB(B1, 0, 1); PG8_SCHED; PG8_LDA(At, 0, 0); PG8_STAGE(PG8_SA(1, 1), a1 + hstep, voffA);
            PG8_WAIT_V(8); PG8_WAIT_L(0); PG8_BAR; PG8_MMA(0, 0, At, B0); PG8_MMA(0, 1, At, B1); PG8_BAR; PG8_SCHED;
            PG8_LDA(At, 0, 1); PG8_STAGE(PG8_SB(0, 0), b2, voffB); PG8_STAGE(PG8_SB(0, 1), b2 + hstep, voffB); PG8_STAGE(PG8_SA(0, 0), a2, voffA);
            PG8_WAIT_V(8); PG8_WAIT_L(0); PG8_BAR; PG8_MMA(1, 0, At, B0); PG8_MMA(1, 1, At, B1); PG8_BAR; PG8_SCHED;
            PG8_LDB(B0, 1, 0); PG8_LDB(B1, 1, 1); PG8_SCHED; PG8_LDA(At, 1, 0); PG8_STAGE(PG8_SA(0, 1), a2 + hstep, voffA);
            PG8_WAIT_V(8); PG8_WAIT_L(0); PG8_BAR; PG8_MMA(0, 0, At, B0); PG8_MMA(0, 1, At, B1); PG8_BAR; PG8_SCHED;
            PG8_LDA(At, 1, 1); PG8_STAGE(PG8_SB(1, 0), b3, voffB); PG8_STAGE(PG8_SB(1, 1), b3 + hstep, voffB); PG8_STAGE(PG8_SA(1, 0), a3, voffA);
            PG8_WAIT_V(8); PG8_WAIT_L(0); PG8_BAR; PG8_MMA(1, 0, At, B0); PG8_MMA(1, 1, At, B1); PG8_BAR; PG8_SCHED;
            } else {
            PG8_LDB(B0, 0, 0); PG8_SCHED; PG8_LDA(At, 0, 0); PG8_STAGE(PG8_SA(1, 1), a1 + hstep, voffA);
            PG8_WAIT_L(8); PG8_BAR; PG8_WAIT_L(0); PG8_MMA(0, 0, At, B0); PG8_BAR; PG8_SCHED;
            PG8_LDB(B1, 0, 1); PG8_STAGE(PG8_SB(0, 0), b2, voffB);
            PG8_BAR; PG8_WAIT_L(0); PG8_MMA(0, 1, At, B1); PG8_BAR;
            PG8_LDA(At, 0, 1); PG8_STAGE(PG8_SA(0, 0), a2, voffA);
            PG8_BAR; PG8_WAIT_L(0); PG8_MMA(1, 0, At, B0); PG8_BAR; PG8_SCHED;
            PG8_STAGE(PG8_SB(0, 1), b2 + hstep, voffB);
            PG8_WAIT_V(6); PG8_BAR; PG8_MMA(1, 1, At, B1); PG8_BAR;
            PG8_LDB(B0, 1, 0); PG8_SCHED; PG8_LDA(At, 1, 0); PG8_STAGE(PG8_SA(0, 1), a2 + hstep, voffA);
            PG8_WAIT_L(8); PG8_BAR; PG8_WAIT_L(0); PG8_MMA(0, 0, At, B0); PG8_BAR; PG8_SCHED;
            PG8_LDB(B1, 1, 1); PG8_STAGE(PG8_SB(1, 0), b3, voffB);
            PG8_BAR; PG8_WAIT_L(0); PG8_MMA(0, 1, At, B1); PG8_BAR;
            PG8_LDA(At, 1, 1); PG8_STAGE(PG8_SA(1, 0), a3, voffA);
            PG8_BAR; PG8_WAIT_L(0); PG8_MMA(1, 0, At, B0); PG8_BAR; PG8_SCHED;
            PG8_STAGE(PG8_SB(1, 1), b3 + hstep, voffB);
            PG8_WAIT_V(6); PG8_BAR; PG8_MMA(1, 1, At, B1); PG8_BAR;
            }
            if constexpr (MIDT > 0) { if (t == MIDT - 2) E.mid(acc, cur, wr, wc, fr, fq); }
        }
        if constexpr (ALIGN_EPI) { if (wr == 0) PG8_BAR; }
        if constexpr (!Epi::AFTER_DRAIN) { E(acc, cur, wr, wc, fr, fq); S.done(cur); }
        if (!has_next) break;
#pragma unroll
        for (int a = 0; a < 2; ++a)
#pragma unroll
            for (int b = 0; b < 2; ++b)
#pragma unroll
                for (int m = 0; m < 4; ++m)
#pragma unroll
                    for (int n = 0; n < 2; ++n) acc[a][b][m][n] = (f32x4){0.f, 0.f, 0.f, 0.f};
        cur = nxt; cA = nA; cB = nB; ++ui;
        if constexpr (ALIGN_EPI) { if (wr == 1) PG8_BAR; }
    }
    PG8_WAIT_V(0);
    if constexpr (!ALIGN_EPI) { if (wr == 0) PG8_BAR; }
    PG8_BAR;
    if constexpr (Epi::AFTER_DRAIN) { E.fused(acc, cur, wr, wc, fr, fq, lds, wid, lane); S.done(cur); }
#undef PG8_SA
#undef PG8_SB
#undef PG8_STAGE
#undef PG8_LDA
#undef PG8_LDB
#undef PG8_MMA
#undef PG8_WAIT_V
#undef PG8_WAIT_L
#undef PG8_BAR
#undef PG8_SCHED
}
}

constexpr int BATCH = 4, SEQ = 4096, DM = 1024, M = BATCH * SEQ, NIN = 5632, FF = 4096, SBW = 512, HGW = 512;
constexpr float EPS = 1e-6f;
constexpr float QSCALE = 0.125f * 1.4426950408889634f;
#define LAS __attribute__((address_space(3)))
typedef unsigned short bf16_t;
typedef short bf16x8 __attribute__((ext_vector_type(8)));
typedef short s16x4 __attribute__((ext_vector_type(4)));
typedef float f32x4 __attribute__((ext_vector_type(4)));
typedef float f32x16 __attribute__((ext_vector_type(16)));
typedef unsigned u32x4 __attribute__((ext_vector_type(4)));
typedef unsigned u32x2 __attribute__((ext_vector_type(2)));
typedef float f32x2_t __attribute__((ext_vector_type(2)));
typedef __bf16 bf16x2_t __attribute__((ext_vector_type(2)));
__device__ __forceinline__ unsigned cvtpk(float lo, float hi) { f32x2_t v = {lo, hi}; bf16x2_t b = __builtin_convertvector(v, bf16x2_t); return __builtin_bit_cast(unsigned, b); }
__device__ __forceinline__ bf16_t cvt1(float x) { return (bf16_t)(cvtpk(x, 0.f) & 0xffffu); }
__device__ __forceinline__ float bf2f(bf16_t b) { return __uint_as_float(((unsigned)b) << 16); }
__device__ __forceinline__ float fexp(float x) { return __builtin_amdgcn_exp2f(x * 1.4426950408889634f); }
__device__ __forceinline__ float fsigmoid(float x) { return __builtin_amdgcn_rcpf(1.0f + __builtin_amdgcn_exp2f(-x * 1.4426950408889634f)); }
__device__ __forceinline__ int crow(int r, int hi) { return (r & 3) + 8 * (r >> 2) + 4 * hi; }
__device__ __forceinline__ bf16x8 pack8(const f32x16& x, int s) {
    u32x4 p; p.x = cvtpk(x[8 * s + 0], x[8 * s + 1]); p.y = cvtpk(x[8 * s + 2], x[8 * s + 3]); p.z = cvtpk(x[8 * s + 4], x[8 * s + 5]); p.w = cvtpk(x[8 * s + 6], x[8 * s + 7]);
    return __builtin_bit_cast(bf16x8, p);
}
#define MFMA32(a, b, c) __builtin_amdgcn_mfma_f32_32x32x16_bf16((a), (b), (c), 0, 0, 0)
typedef short v4i16_t __attribute__((ext_vector_type(4)));
__device__ __forceinline__ bf16x8 trfrag(const LAS unsigned char* p) {
    const s16x4 lo = __builtin_bit_cast(s16x4, __builtin_amdgcn_ds_read_tr16_b64_v4i16((LAS v4i16_t*)p));
    const s16x4 hi = __builtin_bit_cast(s16x4, __builtin_amdgcn_ds_read_tr16_b64_v4i16((LAS v4i16_t*)(p + 512)));
    return (bf16x8){lo[0], lo[1], lo[2], lo[3], hi[0], hi[1], hi[2], hi[3]};
}

namespace pg8 {
struct EpiIn {
    static constexpr bool PERM = true, AFTER_DRAIN = false;
    bf16_t *Q, *K, *V, *I, *QS, *SG, *GA, *GB; float* LF; const float* lbl; const float* bg;
    template <int MODE> __device__ __forceinline__ void body(const f32x4 (&acc)[2][2][4][2], bf16_t* dst, int ldc, int row0, int col0, const float (&aux)[2][8]) const {
#pragma unroll
        for (int ai = 0; ai < 2; ++ai)
#pragma unroll
            for (int m = 0; m < 4; ++m) { const size_t row = (size_t)(row0 + ai * HALF + m * 16);
#pragma unroll
                for (int bj = 0; bj < 2; ++bj) { float v[8];
#pragma unroll
                    for (int j = 0; j < 4; ++j) { v[j] = acc[ai][bj][m][0][j]; v[4 + j] = acc[ai][bj][m][1][j]; }
#pragma unroll
                    for (int j = 0; j < 8; ++j) {
                        if (MODE == 0) v[j] *= QSCALE;
                        if (MODE == 2) { const float sg = fsigmoid(v[j]); const float f = aux[bj][j] + (1.0f - aux[bj][j]) * sg; v[j] = __logf(f); }
                        if (MODE == 3) v[j] = v[j] * fsigmoid(v[j]);
                        if (MODE == 4) v[j] = fsigmoid(v[j] + aux[bj][j]);
                    }
                    if (MODE == 2) { float* p = LF + row * 512 + col0 + bj * HALF; *(f32x4*)p = (f32x4){v[0], v[1], v[2], v[3]}; *(f32x4*)(p + 4) = (f32x4){v[4], v[5], v[6], v[7]}; }
                    else { u32x4 w; w.x = cvtpk(v[0], v[1]); w.y = cvtpk(v[2], v[3]); w.z = cvtpk(v[4], v[5]); w.w = cvtpk(v[6], v[7]); *(u32x4*)(dst + row * ldc + col0 + bj * HALF) = w; }
                } }
    }
    __device__ __forceinline__ void operator()(const f32x4 (&acc)[2][2][4][2], const Unit& u, int wr, int wc, int fr, int fq) const {
        const int pn = u.pn; const int row0 = u.pm * BM + wr * 64 + fr; const int cw = wc * 32 + 8 * fq;
        float aux[2][8];
#pragma unroll
        for (int bj = 0; bj < 2; ++bj)
#pragma unroll
            for (int j = 0; j < 8; ++j) aux[bj][j] = 0.f;
        if (pn < 2) body<0>(acc, Q, 512, row0, pn * 256 + cw, aux);
        else if (pn < 4) body<1>(acc, K, 512, row0, (pn - 2) * 256 + cw, aux);
        else if (pn < 6) body<1>(acc, V, 512, row0, (pn - 4) * 256 + cw, aux);
        else if (pn < 8) { const int c0 = (pn - 6) * 256 + cw;
#pragma unroll
            for (int bj = 0; bj < 2; ++bj)
#pragma unroll
                for (int j = 0; j < 8; ++j) { const int c = c0 + bj * HALF + j; aux[bj][j] = __builtin_amdgcn_rcpf(1.0f + fexp(lbl[512 + c] - lbl[c])); }
            body<2>(acc, nullptr, 512, row0, c0, aux); }
        else if (pn < 10) body<1>(acc, I, 512, row0, (pn - 8) * 256 + cw, aux);
        else if (pn < 12) body<3>(acc, QS, 512, row0, (pn - 10) * 256 + cw, aux);
        else if (pn < 14) body<3>(acc, SG, 512, row0, (pn - 12) * 256 + cw, aux);
        else { const bool second = pn >= 18; const int c0 = (pn - (second ? 18 : 14)) * 256 + cw;
#pragma unroll
            for (int bj = 0; bj < 2; ++bj)
#pragma unroll
                for (int j = 0; j < 8; ++j) aux[bj][j] = bg[(second ? 1024 : 0) + c0 + bj * HALF + j];
            body<4>(acc, second ? GB : GA, 1024, row0, c0, aux); }
    }
};
struct EpiM1 {
    static constexpr bool PERM = true, AFTER_DRAIN = false;
    const bf16_t* GA; float* TMP;
    __device__ __forceinline__ void operator()(const f32x4 (&acc)[2][2][4][2], const Unit& u, int wr, int wc, int fr, int fq) const {
        const int row0 = u.pm * BM + wr * 64 + fr, col0 = u.pn * BM + wc * 32 + 8 * fq;
#pragma unroll
        for (int ai = 0; ai < 2; ++ai)
#pragma unroll
            for (int m = 0; m < 4; ++m) { const size_t off = (size_t)(row0 + ai * HALF + m * 16) * 1024 + col0;
#pragma unroll
                for (int bj = 0; bj < 2; ++bj) { const u32x4 g = *(const u32x4*)(GA + off + bj * HALF); const f32x4 a0 = acc[ai][bj][m][0], a1 = acc[ai][bj][m][1];
                    f32x4 o0, o1; o0.x = a0.x * __uint_as_float(g.x << 16); o0.y = a0.y * __uint_as_float(g.x & 0xffff0000u); o0.z = a0.z * __uint_as_float(g.y << 16); o0.w = a0.w * __uint_as_float(g.y & 0xffff0000u);
                    o1.x = a1.x * __uint_as_float(g.z << 16); o1.y = a1.y * __uint_as_float(g.z & 0xffff0000u); o1.z = a1.z * __uint_as_float(g.w << 16); o1.w = a1.w * __uint_as_float(g.w & 0xffff0000u);
                    float* p = TMP + off + bj * HALF; *(f32x4*)p = o0; *(f32x4*)(p + 4) = o1; } }
    }
};
struct EpiM2 {
    static constexpr bool PERM = true, AFTER_DRAIN = false;
    const bf16_t* GB; const float* TMP; bf16_t* MG;
    __device__ __forceinline__ void operator()(const f32x4 (&acc)[2][2][4][2], const Unit& u, int wr, int wc, int fr, int fq) const {
        const int row0 = u.pm * BM + wr * 64 + fr, col0 = u.pn * BM + wc * 32 + 8 * fq;
#pragma unroll
        for (int ai = 0; ai < 2; ++ai)
#pragma unroll
            for (int m = 0; m < 4; ++m) { const size_t off = (size_t)(row0 + ai * HALF + m * 16) * 1024 + col0;
#pragma unroll
                for (int bj = 0; bj < 2; ++bj) { const u32x4 g = *(const u32x4*)(GB + off + bj * HALF); const f32x4 a0 = acc[ai][bj][m][0], a1 = acc[ai][bj][m][1];
                    const float* p = TMP + off + bj * HALF; const f32x4 t0 = *(const f32x4*)p, t1 = *(const f32x4*)(p + 4);
                    f32x4 o0, o1; o0.x = t0.x + a0.x * __uint_as_float(g.x << 16); o0.y = t0.y + a0.y * __uint_as_float(g.x & 0xffff0000u); o0.z = t0.z + a0.z * __uint_as_float(g.y << 16); o0.w = t0.w + a0.w * __uint_as_float(g.y & 0xffff0000u);
                    o1.x = t1.x + a1.x * __uint_as_float(g.z << 16); o1.y = t1.y + a1.y * __uint_as_float(g.z & 0xffff0000u); o1.z = t1.z + a1.z * __uint_as_float(g.w << 16); o1.w = t1.w + a1.w * __uint_as_float(g.w & 0xffff0000u);
                    u32x4 w; w.x = cvtpk(o0.x, o0.y); w.y = cvtpk(o0.z, o0.w); w.z = cvtpk(o1.x, o1.y); w.w = cvtpk(o1.z, o1.w); *(u32x4*)(MG + off + bj * HALF) = w; } }
    }
};
struct EpiMerge {
    static constexpr bool PERM = true, AFTER_DRAIN = false;
    const bf16_t* GA; const bf16_t* GB; bf16_t* MG;
    __device__ __forceinline__ void mid(f32x4 (&acc)[2][2][4][2], const Unit& u, int wr, int wc, int fr, int fq) const {
        int row0 = u.pm * BM + wr * 64 + fr, col0 = u.pn * BM + wc * 32 + 8 * fq;
        asm volatile("" : "+v"(row0), "+v"(col0));
#pragma unroll
        for (int ai = 0; ai < 2; ++ai)
#pragma unroll
            for (int m = 0; m < 4; ++m) { const size_t off = (size_t)(row0 + ai * HALF + m * 16) * 1024 + col0;
#pragma unroll
                for (int bj = 0; bj < 2; ++bj) { const u32x4 a = *(const u32x4*)(GA + off + bj * HALF), b = *(const u32x4*)(GB + off + bj * HALF);
                    const unsigned aw[4] = {a.x, a.y, a.z, a.w}, bw[4] = {b.x, b.y, b.z, b.w};
#pragma unroll
                    for (int q = 0; q < 4; ++q) { const float r0 = __uint_as_float(aw[q] << 16) * __builtin_amdgcn_rcpf(__uint_as_float(bw[q] << 16)), r1 = __uint_as_float(aw[q] & 0xffff0000u) * __builtin_amdgcn_rcpf(__uint_as_float(bw[q] & 0xffff0000u));
                        acc[ai][bj][m][q >> 1][(q & 1) * 2] *= r0; acc[ai][bj][m][q >> 1][(q & 1) * 2 + 1] *= r1; } }
                asm volatile("" ::: "memory"); }
    }
    __device__ __forceinline__ void operator()(const f32x4 (&acc)[2][2][4][2], const Unit& u, int wr, int wc, int fr, int fq) const {
        const int row0 = u.pm * BM + wr * 64 + fr, col0 = u.pn * BM + wc * 32 + 8 * fq;
#pragma unroll
        for (int ai = 0; ai < 2; ++ai)
#pragma unroll
            for (int m = 0; m < 4; ++m) { const size_t off = (size_t)(row0 + ai * HALF + m * 16) * 1024 + col0;
#pragma unroll
                for (int bj = 0; bj < 2; ++bj) { const u32x4 g = *(const u32x4*)(GB + off + bj * HALF); const f32x4 a0 = acc[ai][bj][m][0], a1 = acc[ai][bj][m][1];
                    u32x4 w; w.x = cvtpk(a0.x * __uint_as_float(g.x << 16), a0.y * __uint_as_float(g.x & 0xffff0000u)); w.y = cvtpk(a0.z * __uint_as_float(g.y << 16), a0.w * __uint_as_float(g.y & 0xffff0000u));
                    w.z = cvtpk(a1.x * __uint_as_float(g.z << 16), a1.y * __uint_as_float(g.z & 0xffff0000u)); w.w = cvtpk(a1.z * __uint_as_float(g.w << 16), a1.w * __uint_as_float(g.w & 0xffff0000u));
                    *(u32x4*)(MG + off + bj * HALF) = w; } }
    }
};
struct EpiRes {
    static constexpr bool PERM = true, AFTER_DRAIN = false;
    const float* BASE; float* OUT; bf16_t* HB; float* SS;
    __device__ __forceinline__ void operator()(const f32x4 (&acc)[2][2][4][2], const Unit& u, int wr, int wc, int fr, int fq) const {
        const int row0 = u.pm * BM + wr * 64 + fr, col0 = u.pn * BM + wc * 32 + 8 * fq;
#pragma unroll
        for (int ai = 0; ai < 2; ++ai)
#pragma unroll
            for (int m = 0; m < 4; ++m) { const int row = row0 + ai * HALF + m * 16; const size_t off = (size_t)row * 1024 + col0; float ss = 0.f;
#pragma unroll
                for (int bj = 0; bj < 2; ++bj) { const float* bp = BASE + off + bj * HALF; const f32x4 o0 = *(const f32x4*)bp + acc[ai][bj][m][0], o1 = *(const f32x4*)(bp + 4) + acc[ai][bj][m][1];
                    float* p = OUT + off + bj * HALF; *(f32x4*)p = o0; *(f32x4*)(p + 4) = o1;
                    ss += (o0.x * o0.x + o0.y * o0.y) + (o0.z * o0.z + o0.w * o0.w) + (o1.x * o1.x + o1.y * o1.y) + (o1.z * o1.z + o1.w * o1.w);
                    if (HB) { u32x4 w; w.x = cvtpk(o0.x, o0.y); w.y = cvtpk(o0.z, o0.w); w.z = cvtpk(o1.x, o1.y); w.w = cvtpk(o1.z, o1.w); *(u32x4*)(HB + off + bj * HALF) = w; } }
                ss += __shfl_xor(ss, 16); ss += __shfl_xor(ss, 32);
                if (fq == 0) unsafeAtomicAdd(SS + row, ss); }
    }
};
struct EpiFF1 {
    static constexpr bool PERM = true, AFTER_DRAIN = false;
    const float* SS; bf16_t* AB;
    __device__ __forceinline__ void operator()(const f32x4 (&acc)[2][2][4][2], const Unit& u, int wr, int wc, int fr, int fq) const {
        const int row0 = u.pm * BM + wr * 64 + fr, col0 = u.pn * BM + wc * 32 + 8 * fq;
#pragma unroll
        for (int ai = 0; ai < 2; ++ai)
#pragma unroll
            for (int m = 0; m < 4; ++m) { const int row = row0 + ai * HALF + m * 16; const float rs = __builtin_amdgcn_rsqf(SS[row] * (1.0f / 1024.0f) + EPS);
#pragma unroll
                for (int bj = 0; bj < 2; ++bj) { float v[8];
#pragma unroll
                    for (int j = 0; j < 4; ++j) { v[j] = acc[ai][bj][m][0][j]; v[4 + j] = acc[ai][bj][m][1][j]; }
#pragma unroll
                    for (int j = 0; j < 8; ++j) { const float t = fmaxf(v[j] * rs, 0.f); v[j] = t * t; }
                    u32x4 w; w.x = cvtpk(v[0], v[1]); w.y = cvtpk(v[2], v[3]); w.z = cvtpk(v[4], v[5]); w.w = cvtpk(v[6], v[7]);
                    *(u32x4*)(AB + (size_t)row * FF + col0 + bj * HALF) = w; } }
    }
};
}

namespace sb {
__device__ __forceinline__ void qk(f32x16& p0, f32x16& p1, const LAS unsigned char* kb, const bf16x8 (&qr)[4]) {
    p0 = (f32x16){}; p1 = (f32x16){};
#pragma unroll
    for (int d0 = 0; d0 < 4; ++d0) { const bf16x8 a0 = *(const LAS bf16x8*)(kb + d0 * 2048), a1 = *(const LAS bf16x8*)(kb + d0 * 2048 + 512);
        p0 = MFMA32(a0, qr[d0], p0); p1 = MFMA32(a1, qr[d0], p1); }
}
template <bool BAND, int LITE> __device__ __forceinline__ void lr(f32x16& p0, f32x16& p1, bf16x8 (&lb)[4], int k0, int qw0, int r32, int hi) {
    if (BAND) { const int qpos = qw0 + r32;
#pragma unroll
        for (int r = 0; r < 16; ++r) { const int key = k0 + crow(r, hi); if (key >= qpos) p0[r] = -INFINITY; if (key + 32 >= qpos) p1[r] = -INFINITY; } }
    f32x16 l0, l1;
#pragma unroll
    for (int r = 0; r < 16; ++r) { if (LITE) { l0[r] = p0[r] * 0.001f; l1[r] = p1[r] * 0.001f; } else { l0[r] = __builtin_amdgcn_logf(1.0f + __builtin_amdgcn_exp2f(p0[r])); l1[r] = __builtin_amdgcn_logf(1.0f + __builtin_amdgcn_exp2f(p1[r])); } }
    lb[0] = pack8(l0, 0); lb[1] = pack8(l0, 1); lb[2] = pack8(l1, 0); lb[3] = pack8(l1, 1);
}
template <bool BAND, int LITE> __device__ __forceinline__ void cum_w(f32x16& p0, f32x16& p1, const bf16x8 (&lb)[4], float& carry, const bf16x8& tf0, const bf16x8& tf1, const bf16x8& ones) {
    f32x16 c0, c1;
#pragma unroll
    for (int r = 0; r < 16; ++r) { c0[r] = p0[r] + carry; c1[r] = p1[r] + carry; }
    const float pz = p0[0];
    f32x16 i1 = MFMA32(tf0, lb[2], c1); i1 = MFMA32(tf1, lb[3], i1);
    f32x16 i0 = MFMA32(ones, lb[2], c0); i0 = MFMA32(ones, lb[3], i0); i0 = MFMA32(tf0, lb[0], i0); i0 = MFMA32(tf1, lb[1], i0);
    float cn = i0[0] - pz; if (BAND) cn = (pz == -INFINITY) ? carry : cn;
    { const unsigned cu = __float_as_uint(cn); auto rr = __builtin_amdgcn_permlane32_swap(cu, cu, false, false); carry = __uint_as_float(rr[0]); }
#pragma unroll
    for (int r = 0; r < 16; ++r) { if (LITE) { p0[r] = i0[r]; p1[r] = i1[r]; } else { p0[r] = __builtin_amdgcn_exp2f(i0[r]); p1[r] = __builtin_amdgcn_exp2f(i1[r]); } }
}
__device__ __forceinline__ void pv(f32x16& o0, f32x16& o1, const f32x16& p0, const f32x16& p1, const LAS unsigned char* vb) {
    const bf16x8 pw0 = pack8(p0, 0), pw1 = pack8(p0, 1), pw2 = pack8(p1, 0), pw3 = pack8(p1, 1);
    { const bf16x8 v0 = trfrag(vb), v1 = trfrag(vb + 1024), v2 = trfrag(vb + 2048), v3 = trfrag(vb + 3072);
      o0 = MFMA32(pw0, v0, o0); o0 = MFMA32(pw1, v1, o0); o0 = MFMA32(pw2, v2, o0); o0 = MFMA32(pw3, v3, o0); }
    { const bf16x8 v0 = trfrag(vb + 4096), v1 = trfrag(vb + 4096 + 1024), v2 = trfrag(vb + 4096 + 2048), v3 = trfrag(vb + 4096 + 3072);
      o1 = MFMA32(pw0, v0, o1); o1 = MFMA32(pw1, v1, o1); o1 = MFMA32(pw2, v2, o1); o1 = MFMA32(pw3, v3, o1); }
}
template <int LITE> __device__ __forceinline__ void unit(int b, int h, int qb, const bf16_t* Q, const bf16_t* __restrict__ K, const bf16_t* __restrict__ V, bf16_t* O, int OP, LAS unsigned char* lds) {
    const int tid = threadIdx.x, lane = tid & 63, r32 = lane & 31, hi = lane >> 5; const int wid = __builtin_amdgcn_readfirstlane(tid >> 6);
    const long rowbase = (long)b * SEQ; const int q0 = qb * 256, qw0 = q0 + wid * 32;
    const bf16_t* Qw = Q + (rowbase + qw0) * SBW + h * 64;
    bf16x8 qr[4];
#pragma unroll
    for (int d0 = 0; d0 < 4; ++d0) qr[d0] = *(const bf16x8*)(Qw + (long)r32 * SBW + d0 * 16 + hi * 8);
    bf16x8 tf0, tf1, ones;
#pragma unroll
    for (int j = 0; j < 8; ++j) { const int kk = 8 * (j >> 2) + 4 * hi + (j & 3); tf0[j] = (kk >= r32) ? (short)0xBF80 : (short)0; tf1[j] = (16 + kk >= r32) ? (short)0xBF80 : (short)0; ones[j] = (short)0xBF80; }
    f32x16 o0 = {}, o1 = {}; float carry = 0.f;
    const int NP = (q0 + 256) / 128;
    const bf16_t* kg = K + (rowbase + (tid & 63)) * SBW + h * 64 + (tid >> 6) * 8;
    const int kl = (tid >> 6) * 1024 + (tid & 63) * 16;
    const bf16_t* vg = V + (rowbase + 16 * (wid & 3) + (lane >> 2)) * SBW + h * 64 + (wid >> 2) * 32 + (lane & 3) * 8;
    const int vl = 32768 + wid * 1024 + lane * 16;
    const int vrd = 32768 + ((lane >> 4) & 1) * 32 + (lane & 3) * 8 + (4 * hi + ((lane & 15) >> 2)) * 64;
    const int krd = hi * 1024 + r32 * 16;
    u32x4 kreg0, kreg1, vreg0, vreg1;
#define SB_LOAD(pp) do { const long ro = (long)(pp) * 128 * SBW; kreg0 = *(const u32x4*)(kg + ro); kreg1 = *(const u32x4*)(kg + ro + 64 * SBW); vreg0 = *(const u32x4*)(vg + ro); vreg1 = *(const u32x4*)(vg + ro + 64 * SBW); } while (0)
#define SB_WRITE(bo) do { *(LAS u32x4*)(lds + (bo) + kl) = kreg0; *(LAS u32x4*)(lds + (bo) + 8192 + kl) = kreg1; *(LAS u32x4*)(lds + (bo) + vl) = vreg0; *(LAS u32x4*)(lds + (bo) + 8192 + vl) = vreg1; } while (0)
    SB_LOAD(NP - 1); SB_WRITE(0);
    int it = 0;
    for (int pp = NP - 1; pp >= NP - 2; --pp, ++it) {
        const int bo = (it & 1) * 16384;
        __syncthreads();
        if (pp > 0) SB_LOAD(pp - 1);
#pragma unroll
        for (int s = 1; s >= 0; --s) { const int k0 = 128 * pp + 64 * s;
            if (k0 <= qw0 + 30) { f32x16 p0, p1; bf16x8 lb[4];
                qk(p0, p1, lds + bo + s * 8192 + krd, qr); lr<true, LITE>(p0, p1, lb, k0, qw0, r32, hi);
                cum_w<true, LITE>(p0, p1, lb, carry, tf0, tf1, ones);
                pv(o0, o1, p0, p1, lds + bo + s * 8192 + vrd); } }
        if (pp > 0) { const int bn = ((it + 1) & 1) * 16384; SB_WRITE(bn); }
    }
    for (int pp = NP - 3; pp >= 0; --pp, ++it) {
        const int bo = (it & 1) * 16384;
        __syncthreads();
        if (pp > 0) SB_LOAD(pp - 1);
        { f32x16 pa0, pa1, pb0, pb1; bf16x8 la[4], lbb[4];
          qk(pa0, pa1, lds + bo + 8192 + krd, qr);
          qk(pb0, pb1, lds + bo + krd, qr);
          lr<false, LITE>(pa0, pa1, la, 0, 0, r32, hi);
          cum_w<false, LITE>(pa0, pa1, la, carry, tf0, tf1, ones);
          pv(o0, o1, pa0, pa1, lds + bo + 8192 + vrd);
          lr<false, LITE>(pb0, pb1, lbb, 0, 0, r32, hi);
          cum_w<false, LITE>(pb0, pb1, lbb, carry, tf0, tf1, ones);
          pv(o0, o1, pb0, pb1, lds + bo + vrd); }
        if (pp > 0) { const int bn = ((it + 1) & 1) * 16384; SB_WRITE(bn); }
    }
#undef SB_LOAD
#undef SB_WRITE
    { LAS bf16_t* stg = (LAS bf16_t*)(lds + 65536 + wid * 4096);
#pragma unroll
      for (int r = 0; r < 16; ++r) { const int orow = crow(r, hi); stg[orow * 64 + r32] = cvt1(o0[r]); stg[orow * 64 + 32 + r32] = cvt1(o1[r]); }
      asm volatile("s_waitcnt lgkmcnt(0)" ::: "memory");
      bf16_t* Ow = O + (rowbase + qw0) * OP + h * 64;
#pragma unroll
      for (int i = 0; i < 4; ++i) { const int row = i * 8 + (lane >> 3), ch = lane & 7; const u32x4 v = *(const LAS u32x4*)(stg + row * 64 + ch * 8); *(u32x4*)(Ow + (long)row * OP + ch * 8) = v; } }
    __syncthreads();
}
template <int LITE> __device__ __forceinline__ void phase(int vcu, int G, const bf16_t* Q, const bf16_t* K, const bf16_t* V, bf16_t* O, int OP, LAS unsigned char* lds) {
    for (int p = vcu; p < 256; p += G) { const int bh = p >> 3, s = p & 7;
        unit<LITE>(bh >> 3, bh & 7, 15 - s, Q, K, V, O, OP, lds);
        unit<LITE>(bh >> 3, bh & 7, s, Q, K, V, O, OP, lds); }
}
}

namespace hg {
constexpr int IMG = 272;
__device__ __forceinline__ void b1_item(int bh, int c, const float* LF, const bf16_t* I, bf16_t* SL, float* DCH, LAS unsigned char* lds) {
    const int tid = threadIdx.x, lane = tid & 63, r32 = lane & 31, hi = lane >> 5; const int wid = __builtin_amdgcn_readfirstlane(tid >> 6);
    const int b = bh >> 2, h = bh & 3; const long rowc = (long)b * SEQ + c * 64;
    const int d = tid & 127, sc = tid >> 7;
    u32x4 vv[2];
#pragma unroll
    for (int i = 0; i < 2; ++i) { const int idx = tid + 512 * i, s = idx >> 4, ch = idx & 15; vv[i] = *(const u32x4*)(I + (rowc + s) * HGW + h * 128 + ch * 8); }
    float lf[16]; { const float* lp = LF + (rowc + 16 * sc) * HGW + h * 128 + d;
#pragma unroll
        for (int i = 0; i < 16; ++i) lf[i] = lp[(long)i * HGW]; }
    float bc[16]; float run = 0.f;
#pragma unroll
    for (int i = 0; i < 16; ++i) { run += lf[i]; bc[i] = run; }
    LAS float* TOT = (LAS float*)lds; TOT[sc * 128 + d] = run;
    LAS unsigned char* VIMG = lds + 2048; LAS unsigned char* KIMG = lds + 2048 + 16384;
#pragma unroll
    for (int i = 0; i < 2; ++i) { const int idx = tid + 512 * i, s = idx >> 4, e0 = (idx & 15) * 8; *(LAS u32x4*)(VIMG + (e0 >> 5) * 4096 + (s >> 4) * 1024 + (s & 15) * 64 + (e0 & 31) * 2) = vv[i]; }
    __syncthreads();
    const float t0 = TOT[d], t1 = TOT[128 + d], t2 = TOT[256 + d], t3 = TOT[384 + d];
    const float pre = (sc > 0 ? t0 : 0.f) + (sc > 1 ? t1 : 0.f) + (sc > 2 ? t2 : 0.f); const float blast = (t0 + t1) + (t2 + t3);
#pragma unroll
    for (int i = 0; i < 16; ++i) { const int s = 16 * sc + i; const float bcum = bc[i] + pre; const float k = 1.0f - fexp(lf[i]); const float kd = k * fexp(blast - bcum);
        *(LAS bf16_t*)(KIMG + (d >> 5) * 4096 + (s >> 4) * 1024 + (s & 15) * 64 + (d & 31) * 2) = cvt1(kd); }
    if (sc == 0) DCH[(size_t)(bh * 64 + c) * 128 + d] = fexp(blast);
    __syncthreads();
    const int eb = wid >> 1, dbp = (wid & 1) * 2;
    const int laneoff = ((lane >> 4) & 1) * 32 + (lane & 3) * 8 + (4 * hi + ((lane & 15) >> 2)) * 64;
    f32x16 a0 = {}, a1 = {};
#pragma unroll
    for (int ks = 0; ks < 4; ++ks) { const bf16x8 A = trfrag(VIMG + eb * 4096 + ks * 1024 + laneoff), B0 = trfrag(KIMG + dbp * 4096 + ks * 1024 + laneoff), B1 = trfrag(KIMG + (dbp + 1) * 4096 + ks * 1024 + laneoff);
        a0 = MFMA32(A, B0, a0); a1 = MFMA32(A, B1, a1); }
    bf16_t* out = SL + (size_t)(bh * 64 + c) * 16384;
#pragma unroll
    for (int r = 0; r < 16; ++r) { const int e = eb * 32 + crow(r, hi); out[e * 128 + dbp * 32 + r32] = cvt1(a0[r]); out[e * 128 + (dbp + 1) * 32 + r32] = cvt1(a1[r]); }
    __syncthreads();
}
__device__ __forceinline__ void b2_scan(int vcu, int G, bf16_t* SL, const float* DCH) {
    const int tid = threadIdx.x;
    for (int w = vcu; w < 128; w += G) { const int bh = w >> 3, part = w & 7; const int base = (part * 512 + tid) * 4, d = base & 127;
        float s0 = 0.f, s1 = 0.f, s2 = 0.f, s3 = 0.f;
        bf16_t* p = SL + (size_t)bh * 64 * 16384 + base; const float* dp = DCH + (size_t)bh * 64 * 128 + d;
        for (int c0 = 0; c0 < 64; c0 += 8) { u32x2 sv[8]; f32x4 dd[8];
#pragma unroll
            for (int j = 0; j < 8; ++j) { sv[j] = *(const u32x2*)(p + (size_t)(c0 + j) * 16384); dd[j] = *(const f32x4*)(dp + (c0 + j) * 128); }
#pragma unroll
            for (int j = 0; j < 8; ++j) { u32x2 w2; w2.x = cvtpk(s0, s1); w2.y = cvtpk(s2, s3); *(u32x2*)(p + (size_t)(c0 + j) * 16384) = w2;
                s0 = dd[j].x * s0 + __uint_as_float(sv[j].x << 16); s1 = dd[j].y * s1 + __uint_as_float(sv[j].x & 0xffff0000u); s2 = dd[j].z * s2 + __uint_as_float(sv[j].y << 16); s3 = dd[j].w * s3 + __uint_as_float(sv[j].y & 0xffff0000u); } }
    }
}
__device__ __forceinline__ void b3_item(int bh, int c, const float* LF, const bf16_t* QS, const bf16_t* I, const bf16_t* SG, const bf16_t* ST, const float* hgn, bf16_t* OHG, LAS unsigned char* lds) {
    const int tid = threadIdx.x, lane = tid & 63, r32 = lane & 31, hi = lane >> 5; const int wid = __builtin_amdgcn_readfirstlane(tid >> 6);
    const int b = bh >> 2, h = bh & 3; const long rowc = (long)b * SEQ + c * 64;
    const int d = tid & 127, sc = tid >> 7; const int tm = wid >> 2, en = wid & 3;
    bf16x8 sf[8]; { const bf16_t* sp = ST + (size_t)(bh * 64 + c) * 16384 + (en * 32 + r32) * 128 + hi * 8;
#pragma unroll
        for (int ks = 0; ks < 8; ++ks) sf[ks] = *(const bf16x8*)(sp + ks * 16); }
    u32x4 vv[2];
#pragma unroll
    for (int i = 0; i < 2; ++i) { const int idx = tid + 512 * i, s = idx >> 4, ch = idx & 15; vv[i] = *(const u32x4*)(I + (rowc + s) * HGW + h * 128 + ch * 8); }
    float lf[16]; float qv[16]; { const float* lp = LF + (rowc + 16 * sc) * HGW + h * 128 + d; const bf16_t* qp = QS + (rowc + 16 * sc) * HGW + h * 128 + d;
#pragma unroll
        for (int i = 0; i < 16; ++i) { lf[i] = lp[(long)i * HGW]; qv[i] = bf2f(qp[(long)i * HGW]); } }
    float bc[16]; float run = 0.f;
#pragma unroll
    for (int i = 0; i < 16; ++i) { run += lf[i]; bc[i] = run; }
    LAS float* TOT = (LAS float*)lds; TOT[sc * 128 + d] = run;
    LAS unsigned char* QT = lds + 2048; LAS unsigned char* QA = lds + 19456; LAS unsigned char* K1 = lds + 36864; LAS unsigned char* K0 = lds + 54272; LAS unsigned char* VIMG = lds + 62976;
#pragma unroll
    for (int i = 0; i < 2; ++i) { const int idx = tid + 512 * i, s = idx >> 4, e0 = (idx & 15) * 8; *(LAS u32x4*)(VIMG + (e0 >> 5) * 4096 + (s >> 4) * 1024 + (s & 15) * 64 + (e0 & 31) * 2) = vv[i]; }
    __syncthreads();
    { const float t0 = TOT[d], t1 = TOT[128 + d], t2 = TOT[256 + d];
      const float pre = (sc > 0 ? t0 : 0.f) + (sc > 1 ? t1 : 0.f) + (sc > 2 ? t2 : 0.f); const float ref1 = t0 + t1; const float ref = (sc >= 2) ? ref1 : 0.f;
#pragma unroll
      for (int i = 0; i < 16; ++i) { const int s = 16 * sc + i; const float bcum = bc[i] + pre; const float k = 1.0f - fexp(lf[i]); const int off = s * IMG + d * 2;
          *(LAS bf16_t*)(QA + off) = cvt1(qv[i] * fexp(bcum));
          *(LAS bf16_t*)(QT + off) = cvt1(qv[i] * fexp(bcum - ref));
          *(LAS bf16_t*)(K1 + off) = cvt1(k * fexp(fminf(ref1 - bcum, 80.f)));
          if (sc < 2) *(LAS bf16_t*)(K0 + off) = cvt1(k * fexp(fminf(-bcum, 80.f))); } }
    __syncthreads();
    f32x16 o = {};
    { const LAS unsigned char* ap = QA + (32 * tm + r32) * IMG + hi * 16;
#pragma unroll
      for (int ks = 0; ks < 8; ++ks) o = MFMA32(*(const LAS bf16x8*)(ap + ks * 32), sf[ks], o); }
    const int laneoff = ((lane >> 4) & 1) * 32 + (lane & 3) * 8 + (4 * hi + ((lane & 15) >> 2)) * 64;
    const LAS unsigned char* kimg = tm ? K1 : K0;
    const LAS unsigned char* qp2 = QT + (32 * tm + r32) * IMG + hi * 16;
    for (int sh = 0; sh <= tm; ++sh) {
        f32x16 s_ = {};
        const LAS unsigned char* kp = kimg + (32 * sh + r32) * IMG + hi * 16;
#pragma unroll
        for (int ks = 0; ks < 8; ++ks) s_ = MFMA32(*(const LAS bf16x8*)(kp + ks * 32), *(const LAS bf16x8*)(qp2 + ks * 32), s_);
        if (sh == tm) {
#pragma unroll
            for (int r = 0; r < 16; ++r) if (crow(r, hi) > r32) s_[r] = 0.f; }
        const bf16x8 pa = pack8(s_, 0), pb = pack8(s_, 1);
        const bf16x8 vf0 = trfrag(VIMG + en * 4096 + (2 * sh) * 1024 + laneoff), vf1 = trfrag(VIMG + en * 4096 + (2 * sh + 1) * 1024 + laneoff);
        o = MFMA32(pa, vf0, o); o = MFMA32(pb, vf1, o);
    }
    __syncthreads();
    LAS float* OS = (LAS float*)(lds + 2048);
#pragma unroll
    for (int r = 0; r < 16; ++r) OS[(32 * tm + crow(r, hi)) * 132 + en * 32 + r32] = o[r];
    __syncthreads();
    { const int t = tid >> 3, j = tid & 7; float v[16]; float ss = 0.f;
#pragma unroll
      for (int q = 0; q < 4; ++q) { const f32x4 x = *(const LAS f32x4*)(OS + t * 132 + j * 16 + q * 4); v[4 * q] = x.x; v[4 * q + 1] = x.y; v[4 * q + 2] = x.z; v[4 * q + 3] = x.w; ss += (x.x * x.x + x.y * x.y) + (x.z * x.z + x.w * x.w); }
      ss += __shfl_xor(ss, 1); ss += __shfl_xor(ss, 2); ss += __shfl_xor(ss, 4);
      const float rs = __builtin_amdgcn_rsqf(ss * (1.0f / 128.0f) + EPS);
      const size_t go = (size_t)(rowc + t) * HGW + h * 128 + j * 16; const float* gp = hgn + h * 128 + j * 16;
      const u32x4 g0 = *(const u32x4*)(SG + go), g1 = *(const u32x4*)(SG + go + 8);
      const unsigned gw[8] = {g0.x, g0.y, g0.z, g0.w, g1.x, g1.y, g1.z, g1.w}; unsigned ow[8];
#pragma unroll
      for (int q = 0; q < 8; ++q) { const float y0 = v[2 * q] * rs * gp[2 * q] * __uint_as_float(gw[q] << 16), y1 = v[2 * q + 1] * rs * gp[2 * q + 1] * __uint_as_float(gw[q] & 0xffff0000u); ow[q] = cvtpk(y0, y1); }
      bf16_t* op = OHG + (size_t)(rowc + t) * 1024 + 512 + h * 128 + j * 16;
      *(u32x4*)op = (u32x4){ow[0], ow[1], ow[2], ow[3]}; *(u32x4*)(op + 8) = (u32x4){ow[4], ow[5], ow[6], ow[7]}; }
    __syncthreads();
}
}


#define XB_TMO      128
#define XB_XCNT(j)  (256  + 64 * (j))
#define XB_XSUB(j)  (1280 + 64 * (j))
#define XB_XGEN(j)  (2304 + 64 * (j))
#define XB_TOP      3328
#define XB_TOPGEN   3392
#define XCD_BAR_WORDS 3456
#define XB_SPIN_CAP (1u << 18)

__device__ __forceinline__ unsigned xb_ld(unsigned* p)              { return __hip_atomic_load(p, __ATOMIC_RELAXED, __HIP_MEMORY_SCOPE_AGENT); }
__device__ __forceinline__ unsigned xb_add(unsigned* p, unsigned v) { return __hip_atomic_fetch_add(p, v, __ATOMIC_RELAXED, __HIP_MEMORY_SCOPE_AGENT); }
__device__ __forceinline__ unsigned xb_xcc_id() { return (unsigned)__builtin_amdgcn_s_getreg((3 << 11) | 20) & 0xFu; }
#define XB_SPIN(cond, bar) do { unsigned _sp = 0; while (cond) { __builtin_amdgcn_s_sleep(1); \
    if ((++_sp & 255u) == 0u) { if (xb_ld(&(bar)[XB_TMO])) break; if (_sp > XB_SPIN_CAP) { atomicAdd(&(bar)[XB_TMO], 1u); break; } } } } while (0)

struct XcdBarrier {
    unsigned* bar; unsigned x;
    volatile LAS unsigned* st;
};

__device__ __forceinline__ XcdBarrier xcd_barrier_post(unsigned* bar, volatile LAS unsigned* st) {
    XcdBarrier b; b.bar = bar; b.x = xb_xcc_id(); b.st = st;
    if (threadIdx.x == 0) (void)xb_add(&bar[XB_XCNT(b.x)], 1u);
    return b;
}
__device__ __forceinline__ void xcd_barrier_complete(unsigned* bar, unsigned x, unsigned& nloc, unsigned& nx) {
    const unsigned G = gridDim.x * gridDim.y * gridDim.z;
    unsigned sum, cnt, mine, sp = 0u;
    for (;;) {
        sum = 0u; cnt = 0u; mine = 0u;
#pragma unroll
        for (unsigned j = 0; j < 16; ++j) { const unsigned c = xb_ld(&bar[XB_XCNT(j)]); sum += c; cnt += (c > 0u) ? 1u : 0u; mine = (j == x) ? c : mine; }
        if (sum == G) break;
        __builtin_amdgcn_s_sleep(1);
        if ((++sp & 255u) == 0u) { if (xb_ld(&bar[XB_TMO])) break; if (sp > XB_SPIN_CAP) { atomicAdd(&bar[XB_TMO], 1u); break; } }
    }
    nloc = mine > 0u ? mine : 1u; nx = cnt > 0u ? cnt : 1u;
}

__device__ __forceinline__ void xcd_barrier(const XcdBarrier& b) {
    asm volatile("s_waitcnt vmcnt(0)" ::: "memory");
    __syncthreads();
    if (threadIdx.x == 0) {
        unsigned* bar = b.bar;
        __builtin_amdgcn_s_waitcnt(0);
        unsigned nloc = b.st[0], nx = b.st[1];
        if (nloc == 0u) { xcd_barrier_complete(bar, b.x, nloc, nx); b.st[0] = nloc; b.st[1] = nx; }
        const unsigned old = xb_add(&bar[XB_XSUB(b.x)], 1u);
        const unsigned gen = old / nloc;
        if (old + 1u == (gen + 1u) * nloc) {
            __builtin_amdgcn_fence(__ATOMIC_RELEASE, "agent");
            asm volatile("s_waitcnt vmcnt(0)" ::: "memory");
            const unsigned og = xb_add(&bar[XB_TOP], 1u);
            const unsigned tg = og / nx;
            if (og + 1u == (tg + 1u) * nx) xb_add(&bar[XB_TOPGEN], 1u);
            else XB_SPIN(xb_ld(&bar[XB_TOPGEN]) == tg, bar);
            __builtin_amdgcn_fence(__ATOMIC_ACQUIRE, "agent");
            xb_add(&bar[XB_XGEN(b.x)], 1u);
            asm volatile("s_waitcnt vmcnt(0)" ::: "memory");
        } else {
            XB_SPIN(xb_ld(&bar[XB_XGEN(b.x)]) == gen, bar);
            __builtin_amdgcn_fence(__ATOMIC_ACQUIRE, "agent");
            asm volatile("s_waitcnt vmcnt(0)" ::: "memory");
        }
    }
    __syncthreads();
}

constexpr int NWAVES = 8;
#ifndef PROBE_MODE
#define PROBE_MODE 0
#endif
#ifndef MK_PER_PHASE
#define MK_PER_PHASE 0
#endif
constexpr int N_PHASES = 10;
constexpr size_t MiB = 1u << 20;
constexpr size_t WS_SS1 = 0, WS_SS2 = 65536, WS_BAR = 131072, WS_BAR_BYTES = 16384, WS_DCH = 262144;
constexpr size_t WS_WIN = 1 * MiB, WS_WOSB = 12 * MiB, WS_WOHG = 13 * MiB, WS_WOUT = 14 * MiB, WS_WFF1 = 16 * MiB, WS_WFF2 = 24 * MiB;
constexpr size_t WS_XN = 32 * MiB;
constexpr size_t WS_Q = 64 * MiB, WS_K = 80 * MiB, WS_V = 96 * MiB;
constexpr size_t WS_LF = 112 * MiB;
constexpr size_t WS_I = 144 * MiB, WS_QS = 160 * MiB, WS_SG = 176 * MiB, WS_OHG = 192 * MiB;
constexpr size_t WS_HB = 208 * MiB;
constexpr size_t WS_TMP = 112 * MiB;
constexpr size_t WS_AB = 64 * MiB;
constexpr size_t WS_END = 240 * MiB;
constexpr int RING_BYTES = 131072, LDS_BYTES = 147456;

__device__ __forceinline__ float wave_sum(float v) {
#pragma unroll
    for (int o = 1; o < 64; o <<= 1) v += __shfl_xor(v, o);
    return v;
}
__device__ __forceinline__ void p0_transpose_item(const float* W, int K, int N, bf16_t* WT, int pitch, const float* kscale, LAS float* scr, int item, int lane) {
    const int nblk = N / 32, kb = item / nblk, nb = item % nblk, k0 = 64 * kb, n0 = 32 * nb;
#pragma unroll 8
    for (int i = 0; i < 32; ++i) { const int kk = 2 * i + (lane >> 5); float w = W[(size_t)(k0 + kk) * N + n0 + (lane & 31)]; if (kscale) w *= kscale[k0 + kk]; scr[kk * 33 + (lane & 31)] = w; }
    asm volatile("s_waitcnt lgkmcnt(0)" ::: "memory");
    const int c = lane & 7;
#pragma unroll
    for (int j = 0; j < 4; ++j) { const int n = (lane >> 3) + 8 * j; const LAS float* s = scr + (8 * c) * 33 + n;
        u32x4 o; o.x = cvtpk(s[0 * 33], s[1 * 33]); o.y = cvtpk(s[2 * 33], s[3 * 33]); o.z = cvtpk(s[4 * 33], s[5 * 33]); o.w = cvtpk(s[6 * 33], s[7 * 33]);
        *(u32x4*)(WT + (size_t)(n0 + n) * pitch + k0 + 8 * c) = o; }
    asm volatile("s_waitcnt lgkmcnt(0)" ::: "memory");
}

struct Args { const float* in[13]; float* out; unsigned char* ws; int ph_lo, ph_hi; };
__global__ void __launch_bounds__(NWAVES * 64, 2) fwd_kernel(Args args) {
    extern __shared__ __attribute__((aligned(16))) unsigned char lds_raw[];
    LAS unsigned char* lds = (LAS unsigned char*)lds_raw;
    const int tid = threadIdx.x, lane = tid & 63, wave = __builtin_amdgcn_readfirstlane(tid >> 6);
    const int G = gridDim.x; const int bx = blockIdx.x; const int vcu = (G % 8 == 0) ? (bx % 8) * (G / 8) + bx / 8 : bx;
    unsigned char* ws = args.ws;
    const float* x = args.in[0]; const float* norm1_g = args.in[1]; const float* w_in = args.in[2]; const float* b_gate = args.in[3]; const float* lb_logits = args.in[4];
    const float* hg_norm_g = args.in[5]; const float* w_o_sb = args.in[6]; const float* w_o_hg = args.in[7]; const float* w_out = args.in[8]; const float* norm2_g = args.in[9];
    const float* w_ff1 = args.in[10]; const float* w_ff2 = args.in[11]; const float* final_g = args.in[12];
    float* out = args.out;
    float* SS1 = (float*)(ws + WS_SS1); float* SS2 = (float*)(ws + WS_SS2); float* DCH = (float*)(ws + WS_DCH);
    bf16_t* WIN = (bf16_t*)(ws + WS_WIN); bf16_t* WOSB = (bf16_t*)(ws + WS_WOSB); bf16_t* WOHG = (bf16_t*)(ws + WS_WOHG); bf16_t* WOUT = (bf16_t*)(ws + WS_WOUT);
    bf16_t* WFF1 = (bf16_t*)(ws + WS_WFF1); bf16_t* WFF2 = (bf16_t*)(ws + WS_WFF2);
    bf16_t* XN = (bf16_t*)(ws + WS_XN); bf16_t* SL = XN; bf16_t* MG = XN;
    bf16_t* QB = (bf16_t*)(ws + WS_Q); bf16_t* KB = (bf16_t*)(ws + WS_K); bf16_t* VB = (bf16_t*)(ws + WS_V); float* LF = (float*)(ws + WS_LF);
    bf16_t* IB = (bf16_t*)(ws + WS_I); bf16_t* QS = (bf16_t*)(ws + WS_QS); bf16_t* SG = (bf16_t*)(ws + WS_SG); bf16_t* OHG = (bf16_t*)(ws + WS_OHG);
    bf16_t* HB = (bf16_t*)(ws + WS_HB); bf16_t* O2 = HB;   float* TMP = (float*)(ws + WS_TMP); bf16_t* AB = (bf16_t*)(ws + WS_AB);
    bf16_t* GA = (bf16_t*)out; bf16_t* GB = GA + (size_t)M * 1024;
    const int lo = args.ph_lo, hi = args.ph_hi;
    volatile LAS unsigned* bst = (volatile LAS unsigned*)(lds + RING_BYTES + 64);
    if (tid < 2) bst[tid] = 0u;
    __syncthreads();
    XcdBarrier bar = xcd_barrier_post((unsigned*)(ws + WS_BAR), bst);
    if (lo < 0) cg::this_grid().sync();
#define IN(k) (lo <= (k) && (k) < hi)
#define SEAM(k) do { if (IN(k) && IN((k) + 1)) { xcd_barrier(bar); if (PROBE_MODE == 3) xcd_barrier(bar); } } while (0)

    if (IN(0)) _Pragma("nounroll") for (int rep = 0; rep < (PROBE_MODE == 7 ? 2 : 1); ++rep) {
        LAS float* scr = (LAS float*)(lds + wave * 16384);
        const int gw = vcu * NWAVES + wave, NGW = G * NWAVES;
        constexpr int I_IN = (DM / 64) * (NIN / 32), I_OS = (512 / 64) * (DM / 32), I_OUT = (DM / 64) * (DM / 32), I_F1 = (DM / 64) * (FF / 32), I_F2 = (FF / 64) * (DM / 32);
        constexpr int NITEMS = I_IN + 2 * I_OS + I_OUT + I_F1 + I_F2;
        for (int it = gw; it < NITEMS; it += NGW) { int r = it;
            if (r < I_IN) { p0_transpose_item(w_in, DM, NIN, WIN, DM, nullptr, scr, r, lane); continue; } r -= I_IN;
            if (r < I_OS) { p0_transpose_item(w_o_sb, 512, DM, WOSB, 1024, nullptr, scr, r, lane); continue; } r -= I_OS;
            if (r < I_OS) { p0_transpose_item(w_o_hg, 512, DM, WOSB + 512, 1024, nullptr, scr, r, lane); continue; } r -= I_OS;
            if (r < I_OUT) { p0_transpose_item(w_out, DM, DM, WOUT, DM, nullptr, scr, r, lane); continue; } r -= I_OUT;
            if (r < I_F1) { p0_transpose_item(w_ff1, DM, FF, WFF1, DM, norm2_g, scr, r, lane); continue; } r -= I_F1;
            p0_transpose_item(w_ff2, FF, DM, WFF2, FF, nullptr, scr, r, lane); }
        for (int m = gw; m < M; m += NGW) { const f32x4* xr = (const f32x4*)(x + (size_t)m * DM) + lane; f32x4 v[4]; float s = 0.f;
#pragma unroll
            for (int j = 0; j < 4; ++j) { v[j] = xr[64 * j]; s += (v[j].x * v[j].x + v[j].y * v[j].y) + (v[j].z * v[j].z + v[j].w * v[j].w); }
            const float rs = __builtin_amdgcn_rsqf(wave_sum(s) * (1.0f / DM) + EPS);
            u32x2* o8 = (u32x2*)(XN + (size_t)m * DM) + lane;
#pragma unroll
            for (int j = 0; j < 4; ++j) { const f32x4 g = ((const f32x4*)norm1_g)[lane + 64 * j]; u32x2 w; w.x = cvtpk(v[j].x * rs * g.x, v[j].y * rs * g.y); w.y = cvtpk(v[j].z * rs * g.z, v[j].w * rs * g.w); o8[64 * j] = w; } }
        for (int i = bx * 512 + tid; i < 2 * M; i += G * 512) { if (i < M) SS1[i] = 0.f; else SS2[i - M] = 0.f; }
    }
    SEAM(0);
    if (IN(1)) { pg8::Gemm g{XN, WIN, M, NIN, DM}; pg8::StaticOrder S; S.init(M, NIN, G, bx);
        pg8::EpiIn E{QB, KB, VB, IB, QS, SG, GA, GB, LF, lb_logits, b_gate};
        _Pragma("nounroll") for (int rep = 0; rep < (PROBE_MODE == 4 ? 2 : 1); ++rep) pg8::gemm_phase<pg8::EpiIn, pg8::StaticOrder, true, true>(lds, g, S, E); }
    SEAM(1);
    if (IN(2)) { for (int rep = 0; rep < (PROBE_MODE == 2 ? 2 : 1); ++rep) for (int it = vcu; it < 1024; it += G) hg::b1_item(it >> 6, it & 63, LF, IB, SL, DCH, lds); }
    SEAM(2);
    if (IN(3)) { hg::b2_scan(vcu, G, SL, DCH); if (PROBE_MODE == 1) sb::phase<0>(vcu, G, QB, KB, VB, OHG, 512, lds); if (PROBE_MODE == 8) sb::phase<1>(vcu, G, QB, KB, VB, OHG, 512, lds); sb::phase<0>(vcu, G, QB, KB, VB, O2, 1024, lds); }
    SEAM(3);
    if (IN(4)) { for (int rep = 0; rep < (PROBE_MODE == 2 ? 2 : 1); ++rep) for (int it = vcu; it < 1024; it += G) hg::b3_item(it >> 6, it & 63, LF, QS, IB, SG, SL, hg_norm_g, O2, lds); }
    SEAM(4);
    if (IN(5)) { pg8::Gemm g{O2, WOSB, M, DM, DM}; pg8::StaticOrder S; S.init(M, DM, G, bx); pg8::EpiMerge E{GA, GB, MG};
        pg8::gemm_phase<pg8::EpiMerge, pg8::StaticOrder, true, true, 8>(lds, g, S, E); }
    SEAM(5);
    if (IN(6)) { pg8::Gemm g{MG, WOUT, M, DM, DM}; pg8::StaticOrder S; S.init(M, DM, G, bx); pg8::EpiRes E{x, out, HB, SS1}; pg8::gemm_phase<pg8::EpiRes, pg8::StaticOrder, true, true>(lds, g, S, E); }
    SEAM(6);
    if (IN(7)) { pg8::Gemm g{HB, WFF1, M, FF, DM}; pg8::StaticOrder S; S.init(M, FF, G, bx); pg8::EpiFF1 E{SS1, AB}; _Pragma("nounroll") for (int rep = 0; rep < (PROBE_MODE == 6 ? 2 : 1); ++rep) pg8::gemm_phase<pg8::EpiFF1, pg8::StaticOrder, true, true>(lds, g, S, E); }
    SEAM(7);
    if (IN(8)) { pg8::Gemm g{AB, WFF2, M, DM, FF}; pg8::StaticOrder S; S.init(M, DM, G, bx); pg8::EpiRes E{out, out, nullptr, SS2}; pg8::gemm_phase<pg8::EpiRes, pg8::StaticOrder, true, true>(lds, g, S, E); }
    SEAM(8);
    if (IN(9)) { const int gw = vcu * NWAVES + wave, NGW = G * NWAVES;
        for (int m = gw; m < M; m += NGW) { f32x4* xr = (f32x4*)(out + (size_t)m * DM) + lane; const float rs = __builtin_amdgcn_rsqf(SS2[m] * (1.0f / DM) + EPS);
#pragma unroll
            for (int j = 0; j < 4; ++j) { const f32x4 g = ((const f32x4*)final_g)[lane + 64 * j]; f32x4 v = xr[64 * j]; v.x *= rs * g.x; v.y *= rs * g.y; v.z *= rs * g.z; v.w *= rs * g.w; xr[64 * j] = v; } } }
#undef IN
#undef SEAM
}

extern "C" void kernel_launch(void* const* d_in, const int* in_sizes, int n_in, void* d_out, int out_size, void* d_ws, size_t ws_size, hipStream_t stream) {
    static int grid = 0;
    if (grid == 0) {
        if (n_in != 13 || out_size != M * DM || ws_size < WS_END) { fprintf(stderr, "kernel_launch: unexpected problem (n_in %d out %d ws %zu)\n", n_in, out_size, ws_size); grid = -1; return; }
        int dev = 0, cus = 0, per_cu = 0;
        if (hipGetDevice(&dev) != hipSuccess || hipDeviceGetAttribute(&cus, hipDeviceAttributeMultiprocessorCount, dev) != hipSuccess) { grid = -1; return; }
        if (hipFuncSetAttribute((const void*)fwd_kernel, hipFuncAttributeMaxDynamicSharedMemorySize, LDS_BYTES) != hipSuccess) { fprintf(stderr, "kernel_launch: hipFuncSetAttribute failed\n"); grid = -1; return; }
        if (hipOccupancyMaxActiveBlocksPerMultiprocessor(&per_cu, (const void*)fwd_kernel, NWAVES * 64, LDS_BYTES) != hipSuccess || per_cu < 1) { fprintf(stderr, "kernel_launch: occupancy query says %d\n", per_cu); per_cu = 1; }
        (void)hipGetLastError();
        grid = cus;
    }
    if (grid < 0) return;
    if (hipMemsetAsync((char*)d_ws + WS_BAR, 0, WS_BAR_BYTES, stream) != hipSuccess) { fprintf(stderr, "kernel_launch: memset of the barrier words failed\n"); return; }
    Args a{};
    for (int i = 0; i < 13; ++i) a.in[i] = (const float*)d_in[i];
    a.out = (float*)d_out; a.ws = (unsigned char*)d_ws;
#if MK_PER_PHASE
    for (int p = 0; p < N_PHASES; ++p) { a.ph_lo = p; a.ph_hi = p + 1; hipLaunchKernelGGL(fwd_kernel, dim3(grid), dim3(NWAVES * 64), LDS_BYTES, stream, a); }
#else
    a.ph_lo = 0; a.ph_hi = N_PHASES;
    void* kargs[] = {&a};
    const hipError_t e = hipLaunchCooperativeKernel((const void*)fwd_kernel, dim3(grid), dim3(NWAVES * 64), kargs, LDS_BYTES, stream);
    if (e != hipSuccess) fprintf(stderr, "kernel_launch: cooperative launch failed: %s (grid %d)\n", hipGetErrorString(e), grid);
#endif
}
```

```cpp
#include <hip/hip_runtime.h>
#include <hip/hip_cooperative_groups.h>
#include <cstdio>
#include <cstdint>
#include <cmath>
namespace cg = cooperative_groups;
namespace pg8 {
#define PG8_LAS __attribute__((address_space(3)))
typedef unsigned short bf16_t;
typedef short bf16x8 __attribute__((ext_vector_type(8)));
typedef float f32x4 __attribute__((ext_vector_type(4)));
typedef unsigned u32x4 __attribute__((ext_vector_type(4)));
constexpr int BM = 256, BK = 64, HALF = 128, HTB = HALF * BK * 2  , STAGE_BYTES = 8 * HTB, NXCD = 8, WGM = 8;

__host__ __device__ __forceinline__ int lds_byte(int r, int c) { const int st = (r >> 4) * 2 + (c >> 5), rr = r & 15, cc = c & 31, ob = rr * 64 + cc * 2; return st * 1024 + (ob ^ (((ob >> 9) & 1) << 5)); }
__host__ __device__ __forceinline__ void stage_rc(int b, int& R, int& C) { const int st = b / 1024, sb = b % 1024, swz = sb ^ (((sb >> 9) & 1) << 5); R = (st >> 1) * 16 + swz / 64; C = (st & 1) * 32 + (swz % 64) / 2; }
__host__ __device__ __forceinline__ int perm32(int rho) { const int n = rho >> 4, i = rho & 15; return 8 * (i >> 2) + 4 * n + (i & 3); }

struct Unit { int pm, pn; };
struct Gemm { const bf16_t* A; const bf16_t* Bt; int M, N, K; };

struct StaticOrder {
    int nM, nN, nwg, G, c;
    __host__ __device__ void init(int M, int N, int G_, int c_) { nM = M / BM; nN = N / BM; nwg = nM * nN; G = G_; c = c_; }
    __host__ __device__ bool next(int i, Unit& u) const {
        const long L = (long)i * G + c; if (L >= nwg) return false;
        int wgid = (int)L; { const int q = nwg / NXCD, r = nwg % NXCD, xcd = wgid % NXCD, off = wgid / NXCD; wgid = (xcd < r ? xcd * (q + 1) : r * (q + 1) + (xcd - r) * q) + off; }
        const int nig = WGM * nN, gid = wgid / nig, fm = gid * WGM, gsz = (nM - fm) < WGM ? (nM - fm) : WGM;
        u.pm = fm + ((wgid % nig) % gsz); u.pn = (wgid % nig) / gsz; return true;
    }
    __device__ __forceinline__ void a_ready(const Unit&) const {}
    __device__ __forceinline__ void done(const Unit&) const {}
};

__device__ __forceinline__ unsigned cvt_pk_bf16(float lo, float hi) { unsigned r; asm volatile("v_cvt_pk_bf16_f32 %0, %1, %2" : "=v"(r) : "v"(lo), "v"(hi)); return r; }
typedef float f32x2 __attribute__((ext_vector_type(2)));
template <class Epi, class Sched, bool ALIGN_EPI = false, bool SP2 = false, int MIDT = 0>
__device__ __forceinline__ void gemm_phase(PG8_LAS unsigned char* lds, const Gemm g, const Sched& S, const Epi& E) {
    const int tid = threadIdx.x, wid = __builtin_amdgcn_readfirstlane(tid >> 6), lane = tid & 63, wr = wid >> 2, wc = wid & 3, fr = lane & 15, fq = lane >> 4;
    const int K = g.K, nt = K / BK;
    unsigned voffA[2], voffB[2];
#pragma unroll
    for (int i = 0; i < 2; ++i) { int R, C; stage_rc(tid * 16 + i * 8192, R, C); const int Rb = Epi::PERM ? ((R & ~31) + perm32(R & 31)) : R;
        voffA[i] = (unsigned)(R * K + C) * 2u; voffB[i] = (unsigned)(Rb * K + C) * 2u; }
    const size_t kstep = (size_t)(BK * 2);
    const size_t hstep = (size_t)HALF * K * 2;
    const size_t tstep = 2 * hstep;
    const unsigned ldsw = (unsigned)wid * 1024u;
    const int aoff = lds_byte(wr * 64 + fr, fq * 8), boff = lds_byte(wc * 32 + fr, fq * 8);
#define PG8_SA(b, h) (((b) * 2 + (h)) * HTB)
#define PG8_SB(b, h) ((4 + (b) * 2 + (h)) * HTB)
#define PG8_STAGE(bufoff, gbase, voff) do { _Pragma("unroll") for (int _i = 0; _i < 2; ++_i) \
        __builtin_amdgcn_global_load_lds((const unsigned*)((const char*)(gbase) + (voff)[_i]), (PG8_LAS unsigned*)(lds + (bufoff) + ldsw + _i * 8192), 16, 0, 0); } while (0)
#define PG8_LDA(dst, b, h) do { _Pragma("unroll") for (int m = 0; m < 4; ++m) _Pragma("unroll") for (int k = 0; k < 2; ++k) dst[m][k] = *(const PG8_LAS bf16x8*)(lds + PG8_SA(b, h) + aoff + m * 2048 + k * 1024); } while (0)
#define PG8_LDB(dst, b, h) do { _Pragma("unroll") for (int n = 0; n < 2; ++n) _Pragma("unroll") for (int k = 0; k < 2; ++k) dst[n][k] = *(const PG8_LAS bf16x8*)(lds + PG8_SB(b, h) + boff + n * 2048 + k * 1024); } while (0)
#define PG8_MMA(ai, bj, At, Bt) do { __builtin_amdgcn_s_setprio(1); _Pragma("unroll") for (int m = 0; m < 4; ++m) _Pragma("unroll") for (int n = 0; n < 2; ++n) _Pragma("unroll") for (int k = 0; k < 2; ++k) \
        acc[ai][bj][m][n] = __builtin_amdgcn_mfma_f32_16x16x32_bf16(Bt[n][k], At[m][k], acc[ai][bj][m][n], 0, 0, 0); __builtin_amdgcn_s_setprio(0); } while (0)
#define PG8_WAIT_V(n) asm volatile("s_waitcnt vmcnt(" #n ")" ::: "memory")
#define PG8_WAIT_L(n) asm volatile("s_waitcnt lgkmcnt(" #n ")" ::: "memory")
#define PG8_BAR __builtin_amdgcn_s_barrier()
#define PG8_SCHED __builtin_amdgcn_sched_barrier(0)
    Unit cur, nxt; int ui = 0;
    if (!S.next(0, cur)) return;
    f32x4 acc[2][2][4][2];
#pragma unroll
    for (int a = 0; a < 2; ++a)
#pragma unroll
        for (int b = 0; b < 2; ++b)
#pragma unroll
            for (int m = 0; m < 4; ++m)
#pragma unroll
                for (int n = 0; n < 2; ++n) acc[a][b][m][n] = (f32x4){0.f, 0.f, 0.f, 0.f};
    bf16x8 At[4][2], B0[2][2], B1[2][2];
    const char* cA = (const char*)g.A + (size_t)cur.pm * tstep; const char* cB = (const char*)g.Bt + (size_t)cur.pn * tstep;
    S.a_ready(cur);
    if constexpr (SP2) {
        PG8_STAGE(PG8_SB(0, 0), cB, voffB); PG8_STAGE(PG8_SB(0, 1), cB + hstep, voffB); PG8_STAGE(PG8_SA(0, 0), cA, voffA); PG8_STAGE(PG8_SA(0, 1), cA + hstep, voffA);
        if (wr == 1) PG8_BAR;
        PG8_WAIT_V(2); PG8_BAR;
        PG8_STAGE(PG8_SB(1, 0), cB + kstep, voffB); PG8_STAGE(PG8_SA(1, 0), cA + kstep, voffA); PG8_STAGE(PG8_SB(1, 1), cB + hstep + kstep, voffB);
        PG8_WAIT_V(6); PG8_BAR;
    } else {
        PG8_STAGE(PG8_SB(0, 0), cB, voffB); PG8_STAGE(PG8_SA(0, 0), cA, voffA); PG8_STAGE(PG8_SB(0, 1), cB + hstep, voffB); PG8_STAGE(PG8_SA(0, 1), cA + hstep, voffA);
        if (wr == 1) PG8_BAR;
        PG8_WAIT_V(4); PG8_BAR;
        PG8_STAGE(PG8_SB(1, 0), cB + kstep, voffB); PG8_STAGE(PG8_SA(1, 0), cA + kstep, voffA); PG8_STAGE(PG8_SB(1, 1), cB + hstep + kstep, voffB);
        PG8_WAIT_V(6); PG8_BAR;
    }
    for (;;) {
        const bool has_next = S.next(ui + 1, nxt);
        const char* nA = has_next ? (const char*)g.A + (size_t)nxt.pm * tstep : cA; const char* nB = has_next ? (const char*)g.Bt + (size_t)nxt.pn * tstep : cB;
        for (int t = 0; t < nt; t += 2) {
            const bool last = (t == nt - 2);
            const char* a1 = cA + (size_t)(t + 1) * kstep;
            const char* a2 = last ? nA : cA + (size_t)(t + 2) * kstep; const char* b2 = last ? nB : cB + (size_t)(t + 2) * kstep;
            const char* a3 = a2 + kstep; const char* b3 = b2 + kstep;
            if (last && has_next) S.a_ready(nxt);
            if constexpr (SP2) {
            PG8_LDB(B0, 0, 0); PG8_LDB(B1, 0, 1); PG8_SCHED; PG8_LDA(At, 0, 0); PG8_STAGE(PG8_SA(1, 1), a1 + hstep, voffA);
            PG8_WAIT_V(8); PG8_WAIT_L(0); PG8_BAR; PG8_MMA(0, 0, At, B0); PG8_MMA(0, 1, At, B1); PG8_BAR; PG8_SCHED;
            PG8_LDA(At, 0, 1); PG8_STAGE(PG8_SB(0, 0), b2, voffB); PG8_STAGE(PG8_SB(0, 1), b2 + hstep, voffB); PG8_STAGE(PG8_SA(0, 0), a2, voffA);
            PG8_WAIT_V(8); PG8_WAIT_L(0); PG8_BAR; PG8_MMA(1, 0, At, B0); PG8_MMA(1, 1, At, B1); PG8_BAR; PG8_SCHED;
            PG8_LDB(B0, 1, 0); PG8_LDB(B1, 1, 1); PG8_SCHED; PG8_LDA(At, 1, 0); PG8_STAGE(PG8_SA(0, 1), a2 + hstep, voffA);
            PG8_WAIT_V(8); PG8_WAIT_L(0); PG8_BAR; PG8_MMA(0, 0, At, B0); PG8_MMA(0, 1, At, B1); PG8_BAR; PG8_SCHED;
            PG8_LDA(At, 1, 1); PG8_STAGE(PG8_SB(1, 0), b3, voffB); PG8_STAGE(PG8_SB(1, 1), b3 + hstep, voffB); PG8_STAGE(PG8_SA(1, 0), a3, voffA);
            PG8_WAIT_V(8); PG8_WAIT_L(0); PG8_BAR; PG8_MMA(1, 0, At, B0); PG8_MMA(1, 1, At, B1); PG8_BAR; PG8_SCHED;
            } else {
            PG8_LDB(B0, 0, 0); PG8_SCHED; PG8_LDA(At, 0, 0); PG8_STAGE(PG8_SA(1, 1), a1 + hstep, voffA);
            PG8_WAIT_L(8); PG8_BAR; PG8_WAIT_L(0); PG8_MMA(0, 0, At, B0); PG8_BAR; PG8_SCHED;
            PG8_LDB(B1, 0, 1); PG8_STAGE(PG8_SB(0, 0), b2, voffB);
            PG8_BAR; PG8_WAIT_L(0); PG8_MMA(0, 1, At, B1); PG8_BAR;
            PG8_LDA(At, 0, 1); PG8_STAGE(PG8_SA(0, 0), a2, voffA);
            PG8_BAR; PG8_WAIT_L(0); PG8_MMA(1, 0, At, B0); PG8_BAR; PG8_SCHED;
            PG8_STAGE(PG8_SB(0, 1), b2 + hstep, voffB);
            PG8_WAIT_V(6); PG8_BAR; PG8_MMA(1, 1, At, B1); PG8_BAR;
            PG8_LDB(B0, 1, 0); PG8_SCHED; PG8_LDA(At, 1, 0); PG8_STAGE(PG8_SA(0, 1), a2 + hstep, voffA);
            PG8_WAIT_L(8); PG8_BAR; PG8_WAIT_L(0); PG8_MMA(0, 0, At, B0); PG8_BAR; PG8_SCHED;
            PG8_LDB(B1, 1, 1); PG8_STAGE(PG8_SB(1, 0), b3, voffB);
            PG8_BAR; PG8_WAIT_L(0); PG8_MMA(0, 1, At, B1); PG8_BAR;
            PG8_LDA(At, 1, 1); PG8_STAGE(PG8_SA(1, 0), a3, voffA);
            PG8_BAR; PG8_WAIT_L(0); PG8_MMA(1, 0, At, B0); PG8_BAR; PG8_SCHED;
            PG8_STAGE(PG8_SB(1, 1), b3 + hstep, voffB);
            PG8_WAIT_V(6); PG8_BAR; PG8_MMA(1, 1, At, B1); PG8_BAR;
            }
            if constexpr (MIDT > 0) { if (t == MIDT - 2) E.mid(acc, cur, wr, wc, fr, fq); }
        }
        if constexpr (ALIGN_EPI) { if (wr == 0) PG8_BAR; }
        if constexpr (!Epi::AFTER_DRAIN) { E(acc, cur, wr, wc, fr, fq); S.done(cur); }
        if (!has_next) break;
#pragma unroll
        for (int a = 0; a < 2; ++a)
#pragma unroll
            for (int b = 0; b < 2; ++b)
#pragma unroll
                for (int m = 0; m < 4; ++m)
#pragma unroll
                    for (int n = 0; n < 2; ++n) acc[a][b][m][n] = (f32x4){0.f, 0.f, 0.f, 0.f};
        cur = nxt; cA = nA; cB = nB; ++ui;
        if constexpr (ALIGN_EPI) { if (wr == 1) PG8_BAR; }
    }
    PG8_WAIT_V(0);
    if constexpr (!ALIGN_EPI) { if (wr == 0) PG8_BAR; }
    PG8_BAR;
    if constexpr (Epi::AFTER_DRAIN) { E.fused(acc, cur, wr, wc, fr, fq, lds, wid, lane); S.done(cur); }
#undef PG8_SA
#undef PG8_SB
#undef PG8_STAGE
#undef PG8_LDA
#undef PG8_LDB
#undef PG8_MMA
#undef PG8_WAIT_V
#undef PG8_WAIT_L
#undef PG8_BAR
#undef PG8_SCHED
}
}

constexpr int BATCH = 4, SEQ = 4096, DM = 1024, M = BATCH * SEQ, NIN = 5632, FF = 4096, SBW = 512, HGW = 512;
constexpr float EPS = 1e-6f;
constexpr float QSCALE = 0.125f * 1.4426950408889634f;
#define LAS __attribute__((address_space(3)))
typedef unsigned short bf16_t;
typedef short bf16x8 __attribute__((ext_vector_type(8)));
typedef short s16x4 __attribute__((ext_vector_type(4)));
typedef float f32x4 __attribute__((ext_vector_type(4)));
typedef float f32x16 __attribute__((ext_vector_type(16)));
typedef unsigned u32x4 __attribute__((ext_vector_type(4)));
typedef unsigned u32x2 __attribute__((ext_vector_type(2)));
typedef float f32x2_t __attribute__((ext_vector_type(2)));
typedef __bf16 bf16x2_t __attribute__((ext_vector_type(2)));
__device__ __forceinline__ unsigned cvtpk(float lo, float hi) { f32x2_t v = {lo, hi}; bf16x2_t b = __builtin_convertvector(v, bf16x2_t); return __builtin_bit_cast(unsigned, b); }
__device__ __forceinline__ bf16_t cvt1(float x) { return (bf16_t)(cvtpk(x, 0.f) & 0xffffu); }
__device__ __forceinline__ float bf2f(bf16_t b) { return __uint_as_float(((unsigned)b) << 16); }
__device__ __forceinline__ float fexp(float x) { return __builtin_amdgcn_exp2f(x * 1.4426950408889634f); }
__device__ __forceinline__ float fsigmoid(float x) { return __builtin_amdgcn_rcpf(1.0f + __builtin_amdgcn_exp2f(-x * 1.4426950408889634f)); }
__device__ __forceinline__ int crow(int r, int hi) { return (r & 3) + 8 * (r >> 2) + 4 * hi; }
__device__ __forceinline__ bf16x8 pack8(const f32x16& x, int s) {
    u32x4 p; p.x = cvtpk(x[8 * s + 0], x[8 * s + 1]); p.y = cvtpk(x[8 * s + 2], x[8 * s + 3]); p.z = cvtpk(x[8 * s + 4], x[8 * s + 5]); p.w = cvtpk(x[8 * s + 6], x[8 * s + 7]);
    return __builtin_bit_cast(bf16x8, p);
}
#define MFMA32(a, b, c) __builtin_amdgcn_mfma_f32_32x32x16_bf16((a), (b), (c), 0, 0, 0)
typedef short v4i16_t __attribute__((ext_vector_type(4)));
__device__ __forceinline__ bf16x8 trfrag(const LAS unsigned char* p) {
    const s16x4 lo = __builtin_bit_cast(s16x4, __builtin_amdgcn_ds_read_tr16_b64_v4i16((LAS v4i16_t*)p));
    const s16x4 hi = __builtin_bit_cast(s16x4, __builtin_amdgcn_ds_read_tr16_b64_v4i16((LAS v4i16_t*)(p + 512)));
    return (bf16x8){lo[0], lo[1], lo[2], lo[3], hi[0], hi[1], hi[2], hi[3]};
}

namespace pg8 {
struct EpiIn {
    static constexpr bool PERM = true, AFTER_DRAIN = false;
    bf16_t *Q, *K, *V, *I, *QS, *SG, *GA, *GB; float* LF; const float* lbl; const float* bg;
    template <int MODE> __device__ __forceinline__ void body(const f32x4 (&acc)[2][2][4][2], bf16_t* dst, int ldc, int row0, int col0, const float (&aux)[2][8]) const {
#pragma unroll
        for (int ai = 0; ai < 2; ++ai)
#pragma unroll
            for (int m = 0; m < 4; ++m) { const size_t row = (size_t)(row0 + ai * HALF + m * 16);
#pragma unroll
                for (int bj = 0; bj < 2; ++bj) { float v[8];
#pragma unroll
                    for (int j = 0; j < 4; ++j) { v[j] = acc[ai][bj][m][0][j]; v[4 + j] = acc[ai][bj][m][1][j]; }
#pragma unroll
                    for (int j = 0; j < 8; ++j) {
                        if (MODE == 0) v[j] *= QSCALE;
                        if (MODE == 2) { const float sg = fsigmoid(v[j]); const float f = aux[bj][j] + (1.0f - aux[bj][j]) * sg; v[j] = __logf(f); }
                        if (MODE == 3) v[j] = v[j] * fsigmoid(v[j]);
                        if (MODE == 4) v[j] = fsigmoid(v[j] + aux[bj][j]);
                    }
                    if (MODE == 2) { float* p = LF + row * 512 + col0 + bj * HALF; *(f32x4*)p = (f32x4){v[0], v[1], v[2], v[3]}; *(f32x4*)(p + 4) = (f32x4){v[4], v[5], v[6], v[7]}; }
                    else { u32x4 w; w.x = cvtpk(v[0], v[1]); w.y = cvtpk(v[2], v[3]); w.z = cvtpk(v[4], v[5]); w.w = cvtpk(v[6], v[7]); *(u32x4*)(dst + row * ldc + col0 + bj * HALF) = w; }
                } }
    }
    __device__ __forceinline__ void operator()(const f32x4 (&acc)[2][2][4][2], const Unit& u, int wr, int wc, int fr, int fq) const {
        const int pn = u.pn; const int row0 = u.pm * BM + wr * 64 + fr; const int cw = wc * 32 + 8 * fq;
        float aux[2][8];
#pragma unroll
        for (int bj = 0; bj < 2; ++bj)
#pragma unroll
            for (int j = 0; j < 8; ++j) aux[bj][j] = 0.f;
        if (pn < 2) body<0>(acc, Q, 512, row0, pn * 256 + cw, aux);
        else if (pn < 4) body<1>(acc, K, 512, row0, (pn - 2) * 256 + cw, aux);
        else if (pn < 6) body<1>(acc, V, 512, row0, (pn - 4) * 256 + cw, aux);
        else if (pn < 8) { const int c0 = (pn - 6) * 256 + cw;
#pragma unroll
            for (int bj = 0; bj < 2; ++bj)
#pragma unroll
                for (int j = 0; j < 8; ++j) { const int c = c0 + bj * HALF + j; aux[bj][j] = __builtin_amdgcn_rcpf(1.0f + fexp(lbl[512 + c] - lbl[c])); }
            body<2>(acc, nullptr, 512, row0, c0, aux); }
        else if (pn < 10) body<1>(acc, I, 512, row0, (pn - 8) * 256 + cw, aux);
        else if (pn < 12) body<3>(acc, QS, 512, row0, (pn - 10) * 256 + cw, aux);
        else if (pn < 14) body<3>(acc, SG, 512, row0, (pn - 12) * 256 + cw, aux);
        else { const bool second = pn >= 18; const int c0 = (pn - (second ? 18 : 14)) * 256 + cw;
#pragma unroll
            for (int bj = 0; bj < 2; ++bj)
#pragma unroll
                for (int j = 0; j < 8; ++j) aux[bj][j] = bg[(second ? 1024 : 0) + c0 + bj * HALF + j];
            body<4>(acc, second ? GB : GA, 1024, row0, c0, aux); }
    }
};
struct EpiM1 {
    static constexpr bool PERM = true, AFTER_DRAIN = false;
    const bf16_t* GA; float* TMP;
    __device__ __forceinline__ void operator()(const f32x4 (&acc)[2][2][4][2], const Unit& u, int wr, int wc, int fr, int fq) const {
        const int row0 = u.pm * BM + wr * 64 + fr, col0 = u.pn * BM + wc * 32 + 8 * fq;
#pragma unroll
        for (int ai = 0; ai < 2; ++ai)
#pragma unroll
            for (int m = 0; m < 4; ++m) { const size_t off = (size_t)(row0 + ai * HALF + m * 16) * 1024 + col0;
#pragma unroll
                for (int bj = 0; bj < 2; ++bj) { const u32x4 g = *(const u32x4*)(GA + off + bj * HALF); const f32x4 a0 = acc[ai][bj][m][0], a1 = acc[ai][bj][m][1];
                    f32x4 o0, o1; o0.x = a0.x * __uint_as_float(g.x << 16); o0.y = a0.y * __uint_as_float(g.x & 0xffff0000u); o0.z = a0.z * __uint_as_float(g.y << 16); o0.w = a0.w * __uint_as_float(g.y & 0xffff0000u);
                    o1.x = a1.x * __uint_as_float(g.z << 16); o1.y = a1.y * __uint_as_float(g.z & 0xffff0000u); o1.z = a1.z * __uint_as_float(g.w << 16); o1.w = a1.w * __uint_as_float(g.w & 0xffff0000u);
                    float* p = TMP + off + bj * HALF; *(f32x4*)p = o0; *(f32x4*)(p + 4) = o1; } }
    }
};
struct EpiM2 {
    static constexpr bool PERM = true, AFTER_DRAIN = false;
    const bf16_t* GB; const float* TMP; bf16_t* MG;
    __device__ __forceinline__ void operator()(const f32x4 (&acc)[2][2][4][2], const Unit& u, int wr, int wc, int fr, int fq) const {
        const int row0 = u.pm * BM + wr * 64 + fr, col0 = u.pn * BM + wc * 32 + 8 * fq;
#pragma unroll
        for (int ai = 0; ai < 2; ++ai)
#pragma unroll
            for (int m = 0; m < 4; ++m) { const size_t off = (size_t)(row0 + ai * HALF + m * 16) * 1024 + col0;
#pragma unroll
                for (int bj = 0; bj < 2; ++bj) { const u32x4 g = *(const u32x4*)(GB + off + bj * HALF); const f32x4 a0 = acc[ai][bj][m][0], a1 = acc[ai][bj][m][1];
                    const float* p = TMP + off + bj * HALF; const f32x4 t0 = *(const f32x4*)p, t1 = *(const f32x4*)(p + 4);
                    f32x4 o0, o1; o0.x = t0.x + a0.x * __uint_as_float(g.x << 16); o0.y = t0.y + a0.y * __uint_as_float(g.x & 0xffff0000u); o0.z = t0.z + a0.z * __uint_as_float(g.y << 16); o0.w = t0.w + a0.w * __uint_as_float(g.y & 0xffff0000u);
                    o1.x = t1.x + a1.x * __uint_as_float(g.z << 16); o1.y = t1.y + a1.y * __uint_as_float(g.z & 0xffff0000u); o1.z = t1.z + a1.z * __uint_as_float(g.w << 16); o1.w = t1.w + a1.w * __uint_as_float(g.w & 0xffff0000u);
                    u32x4 w; w.x = cvtpk(o0.x, o0.y); w.y = cvtpk(o0.z, o0.w); w.z = cvtpk(o1.x, o1.y); w.w = cvtpk(o1.z, o1.w); *(u32x4*)(MG + off + bj * HALF) = w; } }
    }
};
struct EpiMerge {
    static constexpr bool PERM = true, AFTER_DRAIN = false;
    const bf16_t* GA; const bf16_t* GB; bf16_t* MG;
    __device__ __forceinline__ void mid(f32x4 (&acc)[2][2][4][2], const Unit& u, int wr, int wc, int fr, int fq) const {
        int row0 = u.pm * BM + wr * 64 + fr, col0 = u.pn * BM + wc * 32 + 8 * fq;
        asm volatile("" : "+v"(row0), "+v"(col0));
#pragma unroll
        for (int ai = 0; ai < 2; ++ai)
#pragma unroll
            for (int m = 0; m < 4; ++m) { const size_t off = (size_t)(row0 + ai * HALF + m * 16) * 1024 + col0;
#pragma unroll
                for (int bj = 0; bj < 2; ++bj) { const u32x4 a = *(const u32x4*)(GA + off + bj * HALF), b = *(const u32x4*)(GB + off + bj * HALF);
                    const unsigned aw[4] = {a.x, a.y, a.z, a.w}, bw[4] = {b.x, b.y, b.z, b.w};
#pragma unroll
                    for (int q = 0; q < 4; ++q) { const float r0 = __uint_as_float(aw[q] << 16) * __builtin_amdgcn_rcpf(__uint_as_float(bw[q] << 16)), r1 = __uint_as_float(aw[q] & 0xffff0000u) * __builtin_amdgcn_rcpf(__uint_as_float(bw[q] & 0xffff0000u));
                        acc[ai][bj][m][q >> 1][(q & 1) * 2] *= r0; acc[ai][bj][m][q >> 1][(q & 1) * 2 + 1] *= r1; } }
                asm volatile("" ::: "memory"); }
    }
    __device__ __forceinline__ void operator()(const f32x4 (&acc)[2][2][4][2], const Unit& u, int wr, int wc, int fr, int fq) const {
        const int row0 = u.pm * BM + wr * 64 + fr, col0 = u.pn * BM + wc * 32 + 8 * fq;
#pragma unroll
        for (int ai = 0; ai < 2; ++ai)
#pragma unroll
            for (int m = 0; m < 4; ++m) { const size_t off = (size_t)(row0 + ai * HALF + m * 16) * 1024 + col0;
#pragma unroll
                for (int bj = 0; bj < 2; ++bj) { const u32x4 g = *(const u32x4*)(GB + off + bj * HALF); const f32x4 a0 = acc[ai][bj][m][0], a1 = acc[ai][bj][m][1];
                    u32x4 w; w.x = cvtpk(a0.x * __uint_as_float(g.x << 16), a0.y * __uint_as_float(g.x & 0xffff0000u)); w.y = cvtpk(a0.z * __uint_as_float(g.y << 16), a0.w * __uint_as_float(g.y & 0xffff0000u));
                    w.z = cvtpk(a1.x * __uint_as_float(g.z << 16), a1.y * __uint_as_float(g.z & 0xffff0000u)); w.w = cvtpk(a1.z * __uint_as_float(g.w << 16), a1.w * __uint_as_float(g.w & 0xffff0000u));
                    *(u32x4*)(MG + off + bj * HALF) = w; } }
    }
};
struct EpiRes {
    static constexpr bool PERM = true, AFTER_DRAIN = false;
    const float* BASE; float* OUT; bf16_t* HB; float* SS;
    __device__ __forceinline__ void operator()(const f32x4 (&acc)[2][2][4][2], const Unit& u, int wr, int wc, int fr, int fq) const {
        const int row0 = u.pm * BM + wr * 64 + fr, col0 = u.pn * BM + wc * 32 + 8 * fq;
#pragma unroll
        for (int ai = 0; ai < 2; ++ai)
#pragma unroll
            for (int m = 0; m < 4; ++m) { const int row = row0 + ai * HALF + m * 16; const size_t off = (size_t)row * 1024 + col0; float ss = 0.f;
#pragma unroll
                for (int bj = 0; bj < 2; ++bj) { const float* bp = BASE + off + bj * HALF; const f32x4 o0 = *(const f32x4*)bp + acc[ai][bj][m][0], o1 = *(const f32x4*)(bp + 4) + acc[ai][bj][m][1];
                    float* p = OUT + off + bj * HALF; *(f32x4*)p = o0; *(f32x4*)(p + 4) = o1;
                    ss += (o0.x * o0.x + o0.y * o0.y) + (o0.z * o0.z + o0.w * o0.w) + (o1.x * o1.x + o1.y * o1.y) + (o1.z * o1.z + o1.w * o1.w);
                    if (HB) { u32x4 w; w.x = cvtpk(o0.x, o0.y); w.y = cvtpk(o0.z, o0.w); w.z = cvtpk(o1.x, o1.y); w.w = cvtpk(o1.z, o1.w); *(u32x4*)(HB + off + bj * HALF) = w; } }
                ss += __shfl_xor(ss, 16); ss += __shfl_xor(ss, 32);
                if (fq == 0) unsafeAtomicAdd(SS + row, ss); }
    }
};
struct EpiResB {
    static constexpr bool PERM = true, AFTER_DRAIN = false;
    const float* BASEF; const bf16_t* BASEB; bf16_t* OUTB; float* SS;
    __device__ __forceinline__ void operator()(const f32x4 (&acc)[2][2][4][2], const Unit& u, int wr, int wc, int fr, int fq) const {
        const int row0 = u.pm * BM + wr * 64 + fr, col0 = u.pn * BM + wc * 32 + 8 * fq;
#pragma unroll
        for (int ai = 0; ai < 2; ++ai)
#pragma unroll
            for (int m = 0; m < 4; ++m) { const int row = row0 + ai * HALF + m * 16; const size_t off = (size_t)row * 1024 + col0; float ss = 0.f;
#pragma unroll
                for (int bj = 0; bj < 2; ++bj) { f32x4 o0, o1;
                    if (BASEF) { const float* bp = BASEF + off + bj * HALF; o0 = *(const f32x4*)bp; o1 = *(const f32x4*)(bp + 4); }
                    else { const u32x4 g = *(const u32x4*)(BASEB + off + bj * HALF); o0 = (f32x4){__uint_as_float(g.x << 16), __uint_as_float(g.x & 0xffff0000u), __uint_as_float(g.y << 16), __uint_as_float(g.y & 0xffff0000u)};
                        o1 = (f32x4){__uint_as_float(g.z << 16), __uint_as_float(g.z & 0xffff0000u), __uint_as_float(g.w << 16), __uint_as_float(g.w & 0xffff0000u)}; }
                    o0 += acc[ai][bj][m][0]; o1 += acc[ai][bj][m][1];
                    ss += (o0.x * o0.x + o0.y * o0.y) + (o0.z * o0.z + o0.w * o0.w) + (o1.x * o1.x + o1.y * o1.y) + (o1.z * o1.z + o1.w * o1.w);
                    u32x4 w; w.x = cvtpk(o0.x, o0.y); w.y = cvtpk(o0.z, o0.w); w.z = cvtpk(o1.x, o1.y); w.w = cvtpk(o1.z, o1.w); *(u32x4*)(OUTB + off + bj * HALF) = w; }
                ss += __shfl_xor(ss, 16); ss += __shfl_xor(ss, 32);
                if (fq == 0) unsafeAtomicAdd(SS + row, ss); }
    }
};
struct EpiFF1 {
    static constexpr bool PERM = true, AFTER_DRAIN = false;
    const float* SS; bf16_t* AB;
    __device__ __forceinline__ void operator()(const f32x4 (&acc)[2][2][4][2], const Unit& u, int wr, int wc, int fr, int fq) const {
        const int row0 = u.pm * BM + wr * 64 + fr, col0 = u.pn * BM + wc * 32 + 8 * fq;
#pragma unroll
        for (int ai = 0; ai < 2; ++ai)
#pragma unroll
            for (int m = 0; m < 4; ++m) { const int row = row0 + ai * HALF + m * 16; const float rs = __builtin_amdgcn_rsqf(SS[row] * (1.0f / 1024.0f) + EPS);
#pragma unroll
                for (int bj = 0; bj < 2; ++bj) { float v[8];
#pragma unroll
                    for (int j = 0; j < 4; ++j) { v[j] = acc[ai][bj][m][0][j]; v[4 + j] = acc[ai][bj][m][1][j]; }
#pragma unroll
                    for (int j = 0; j < 8; ++j) { const float t = fmaxf(v[j] * rs, 0.f); v[j] = t * t; }
                    u32x4 w; w.x = cvtpk(v[0], v[1]); w.y = cvtpk(v[2], v[3]); w.z = cvtpk(v[4], v[5]); w.w = cvtpk(v[6], v[7]);
                    *(u32x4*)(AB + (size_t)row * FF + col0 + bj * HALF) = w; } }
    }
};
}

namespace sb {
__device__ __forceinline__ void glds16(const void* gsrc, unsigned lds_dst) { unsigned keep;
    asm volatile("s_mov_b32 %0, m0\n\ts_mov_b32 m0, %2\n\ts_nop 0\n\tglobal_load_lds_dwordx4 %1, off\n\ts_mov_b32 m0, %0" : "=&s"(keep) : "v"(gsrc), "s"(lds_dst) : "memory"); }
__device__ __forceinline__ void qk(f32x16& p0, f32x16& p1, const LAS unsigned char* kb, const bf16x8 (&qr)[4]) {
    p0 = (f32x16){}; p1 = (f32x16){};
#pragma unroll
    for (int d0 = 0; d0 < 4; ++d0) { const bf16x8 a0 = *(const LAS bf16x8*)(kb + d0 * 2048), a1 = *(const LAS bf16x8*)(kb + d0 * 2048 + 512);
        p0 = MFMA32(a0, qr[d0], p0); p1 = MFMA32(a1, qr[d0], p1); }
}
template <bool BAND, int LITE> __device__ __forceinline__ void lr(f32x16& p0, f32x16& p1, bf16x8 (&lb)[4], int k0, int qw0, int r32, int hi) {
    if (BAND) { const int qpos = qw0 + r32;
#pragma unroll
        for (int r = 0; r < 16; ++r) { const int key = k0 + crow(r, hi); if (key >= qpos) p0[r] = -INFINITY; if (key + 32 >= qpos) p1[r] = -INFINITY; } }
    f32x16 l0, l1;
#pragma unroll
    for (int r = 0; r < 16; ++r) { if (LITE) { l0[r] = p0[r] * 0.001f; l1[r] = p1[r] * 0.001f; } else { l0[r] = __builtin_amdgcn_logf(1.0f + __builtin_amdgcn_exp2f(p0[r])); l1[r] = __builtin_amdgcn_logf(1.0f + __builtin_amdgcn_exp2f(p1[r])); } }
    lb[0] = pack8(l0, 0); lb[1] = pack8(l0, 1); lb[2] = pack8(l1, 0); lb[3] = pack8(l1, 1);
}
template <bool BAND, int LITE> __device__ __forceinline__ void cum_w(f32x16& p0, f32x16& p1, const bf16x8 (&lb)[4], float& carry, const bf16x8& tf0, const bf16x8& tf1, const bf16x8& ones) {
    f32x16 c0, c1;
#pragma unroll
    for (int r = 0; r < 16; ++r) { c0[r] = p0[r] + carry; c1[r] = p1[r] + carry; }
    const float pz = p0[0];
    f32x16 i1 = MFMA32(tf0, lb[2], c1); i1 = MFMA32(tf1, lb[3], i1);
    f32x16 i0 = MFMA32(ones, lb[2], c0); i0 = MFMA32(ones, lb[3], i0); i0 = MFMA32(tf0, lb[0], i0); i0 = MFMA32(tf1, lb[1], i0);
    float cn = i0[0] - pz; if (BAND) cn = (pz == -INFINITY) ? carry : cn;
    { const unsigned cu = __float_as_uint(cn); auto rr = __builtin_amdgcn_permlane32_swap(cu, cu, false, false); carry = __uint_as_float(rr[0]); }
#pragma unroll
    for (int r = 0; r < 16; ++r) { if (LITE) { p0[r] = i0[r]; p1[r] = i1[r]; } else { p0[r] = __builtin_amdgcn_exp2f(i0[r]); p1[r] = __builtin_amdgcn_exp2f(i1[r]); } }
}
__device__ __forceinline__ void pv(f32x16& o0, f32x16& o1, const f32x16& p0, const f32x16& p1, const LAS unsigned char* vb) {
    const bf16x8 pw0 = pack8(p0, 0), pw1 = pack8(p0, 1), pw2 = pack8(p1, 0), pw3 = pack8(p1, 1);
    { const bf16x8 v0 = trfrag(vb), v1 = trfrag(vb + 1024), v2 = trfrag(vb + 2048), v3 = trfrag(vb + 3072);
      o0 = MFMA32(pw0, v0, o0); o0 = MFMA32(pw1, v1, o0); o0 = MFMA32(pw2, v2, o0); o0 = MFMA32(pw3, v3, o0); }
    { const bf16x8 v0 = trfrag(vb + 4096), v1 = trfrag(vb + 4096 + 1024), v2 = trfrag(vb + 4096 + 2048), v3 = trfrag(vb + 4096 + 3072);
      o1 = MFMA32(pw0, v0, o1); o1 = MFMA32(pw1, v1, o1); o1 = MFMA32(pw2, v2, o1); o1 = MFMA32(pw3, v3, o1); }
}
template <int LITE> __device__ __forceinline__ void unit(int b, int h, int qb, const bf16_t* Q, const bf16_t* __restrict__ K, const bf16_t* __restrict__ V, bf16_t* O, int OP, LAS unsigned char* lds) {
    const int tid = threadIdx.x, lane = tid & 63, r32 = lane & 31, hi = lane >> 5; const int wid = __builtin_amdgcn_readfirstlane(tid >> 6);
    const long rowbase = (long)b * SEQ; const int q0 = qb * 256, qw0 = q0 + wid * 32;
    const bf16_t* Qw = Q + (rowbase + qw0) * SBW + h * 64;
    bf16x8 qr[4];
#pragma unroll
    for (int d0 = 0; d0 < 4; ++d0) qr[d0] = *(const bf16x8*)(Qw + (long)r32 * SBW + d0 * 16 + hi * 8);
    bf16x8 tf0, tf1, ones;
#pragma unroll
    for (int j = 0; j < 8; ++j) { const int kk = 8 * (j >> 2) + 4 * hi + (j & 3); tf0[j] = (kk >= r32) ? (short)0xBF80 : (short)0; tf1[j] = (16 + kk >= r32) ? (short)0xBF80 : (short)0; ones[j] = (short)0xBF80; }
    f32x16 o0 = {}, o1 = {}; float carry = 0.f;
    const int NP = (q0 + 256) / 128;
    const bf16_t* kg = K + (rowbase + lane) * SBW + h * 64 + wid * 8;
    const bf16_t* vg = V + (rowbase + 16 * (wid & 3) + (lane >> 2)) * SBW + h * 64 + (wid >> 2) * 32 + (lane & 3) * 8;
    const int wl = wid * 1024;
    const int vrd = 16384 + ((lane >> 4) & 1) * 32 + (lane & 3) * 8 + (4 * hi + ((lane & 15) >> 2)) * 64;
    const int krd = hi * 1024 + r32 * 16;
    const unsigned lds0 = (unsigned)(uintptr_t)lds + (unsigned)wl;
#define SB_DMA(pp, bo) do { const long ro = (long)(pp) * 128 * SBW; const unsigned ld = (unsigned)__builtin_amdgcn_readfirstlane(lds0 + (unsigned)(bo)); \
        glds16(kg + ro, ld); glds16(kg + ro + 64 * SBW, ld + 8192u); glds16(vg + ro, ld + 16384u); glds16(vg + ro + 64 * SBW, ld + 24576u); } while (0)
    SB_DMA(NP - 1, 0); SB_DMA(NP - 2, 32768);
    asm volatile("" : "+v"(qr[0]), "+v"(qr[1]), "+v"(qr[2]), "+v"(qr[3]));
    int bo = 0, bn2 = 65536;
    for (int it = 0; it < NP; ++it) {
        const int pp = NP - 1 - it;
        if (it + 1 < NP) asm volatile("s_waitcnt vmcnt(4)" ::: "memory"); else asm volatile("s_waitcnt vmcnt(0)" ::: "memory");
        __builtin_amdgcn_s_barrier(); asm volatile("" ::: "memory");
        if (it + 2 < NP) SB_DMA(pp - 2, bn2);
        if (it < 2) {
#pragma unroll
            for (int s = 1; s >= 0; --s) { const int k0 = 128 * pp + 64 * s;
                if (k0 <= qw0 + 30) { f32x16 p0, p1; bf16x8 lb[4];
                    qk(p0, p1, lds + bo + s * 8192 + krd, qr); lr<true, LITE>(p0, p1, lb, k0, qw0, r32, hi);
                    cum_w<true, LITE>(p0, p1, lb, carry, tf0, tf1, ones);
                    pv(o0, o1, p0, p1, lds + bo + s * 8192 + vrd); } }
        } else { f32x16 pa0, pa1, pb0, pb1; bf16x8 la[4], lbb[4];
            qk(pa0, pa1, lds + bo + 8192 + krd, qr);
            qk(pb0, pb1, lds + bo + krd, qr);
            lr<false, LITE>(pa0, pa1, la, 0, 0, r32, hi);
            cum_w<false, LITE>(pa0, pa1, la, carry, tf0, tf1, ones);
            pv(o0, o1, pa0, pa1, lds + bo + 8192 + vrd);
            lr<false, LITE>(pb0, pb1, lbb, 0, 0, r32, hi);
            cum_w<false, LITE>(pb0, pb1, lbb, carry, tf0, tf1, ones);
            pv(o0, o1, pb0, pb1, lds + bo + vrd); }
        bo = (bo == 65536) ? 0 : bo + 32768; bn2 = (bn2 == 65536) ? 0 : bn2 + 32768;
    }
#undef SB_DMA
    { LAS bf16_t* stg = (LAS bf16_t*)(lds + 98304 + wid * 4096);
#pragma unroll
      for (int r = 0; r < 16; ++r) { const int orow = crow(r, hi); stg[orow * 64 + r32] = cvt1(o0[r]); stg[orow * 64 + 32 + r32] = cvt1(o1[r]); }
      asm volatile("s_waitcnt lgkmcnt(0)" ::: "memory");
      bf16_t* Ow = O + (rowbase + qw0) * OP + h * 64;
#pragma unroll
      for (int i = 0; i < 4; ++i) { const int row = i * 8 + (lane >> 3), ch = lane & 7; const u32x4 v = *(const LAS u32x4*)(stg + row * 64 + ch * 8); *(u32x4*)(Ow + (long)row * OP + ch * 8) = v; } }
    __syncthreads();
}
template <int LITE> __device__ __forceinline__ void phase(int vcu, int G, const bf16_t* Q, const bf16_t* K, const bf16_t* V, bf16_t* O, int OP, LAS unsigned char* lds) {
    for (int p = vcu; p < 256; p += G) { const int bh = p >> 3, s = p & 7;
        unit<LITE>(bh >> 3, bh & 7, 15 - s, Q, K, V, O, OP, lds);
        unit<LITE>(bh >> 3, bh & 7, s, Q, K, V, O, OP, lds); }
}
}

namespace hg {
constexpr int IMG = 272;
__device__ __forceinline__ void b1_item(int bh, int c, const float* LF, const bf16_t* I, bf16_t* SL, float* DCH, LAS unsigned char* lds) {
    const int tid = threadIdx.x, lane = tid & 63, r32 = lane & 31, hi = lane >> 5; const int wid = __builtin_amdgcn_readfirstlane(tid >> 6);
    const int b = bh >> 2, h = bh & 3; const long rowc = (long)b * SEQ + c * 64;
    const int d = tid & 127, sc = tid >> 7;
    u32x4 vv[2];
#pragma unroll
    for (int i = 0; i < 2; ++i) { const int idx = tid + 512 * i, s = idx >> 4, ch = idx & 15; vv[i] = *(const u32x4*)(I + (rowc + s) * HGW + h * 128 + ch * 8); }
    float lf[16]; { const float* lp = LF + (rowc + 16 * sc) * HGW + h * 128 + d;
#pragma unroll
        for (int i = 0; i < 16; ++i) lf[i] = lp[(long)i * HGW]; }
    float bc[16]; float run = 0.f;
#pragma unroll
    for (int i = 0; i < 16; ++i) { run += lf[i]; bc[i] = run; }
    LAS float* TOT = (LAS float*)lds; TOT[sc * 128 + d] = run;
    LAS unsigned char* VIMG = lds + 2048; LAS unsigned char* KIMG = lds + 2048 + 16384;
#pragma unroll
    for (int i = 0; i < 2; ++i) { const int idx = tid + 512 * i, s = idx >> 4, e0 = (idx & 15) * 8; *(LAS u32x4*)(VIMG + (e0 >> 5) * 4096 + (s >> 4) * 1024 + (s & 15) * 64 + (e0 & 31) * 2) = vv[i]; }
    __syncthreads();
    const float t0 = TOT[d], t1 = TOT[128 + d], t2 = TOT[256 + d], t3 = TOT[384 + d];
    const float pre = (sc > 0 ? t0 : 0.f) + (sc > 1 ? t1 : 0.f) + (sc > 2 ? t2 : 0.f); const float blast = (t0 + t1) + (t2 + t3);
#pragma unroll
    for (int i = 0; i < 16; ++i) { const int s = 16 * sc + i; const float bcum = bc[i] + pre; const float k = 1.0f - fexp(lf[i]); const float kd = k * fexp(blast - bcum);
        *(LAS bf16_t*)(KIMG + (d >> 5) * 4096 + (s >> 4) * 1024 + (s & 15) * 64 + (d & 31) * 2) = cvt1(kd); }
    if (sc == 0) DCH[(size_t)(bh * 64 + c) * 128 + d] = fexp(blast);
    __syncthreads();
    const int eb = wid >> 1, dbp = (wid & 1) * 2;
    const int laneoff = ((lane >> 4) & 1) * 32 + (lane & 3) * 8 + (4 * hi + ((lane & 15) >> 2)) * 64;
    f32x16 a0 = {}, a1 = {};
#pragma unroll
    for (int ks = 0; ks < 4; ++ks) { const bf16x8 A = trfrag(VIMG + eb * 4096 + ks * 1024 + laneoff), B0 = trfrag(KIMG + dbp * 4096 + ks * 1024 + laneoff), B1 = trfrag(KIMG + (dbp + 1) * 4096 + ks * 1024 + laneoff);
        a0 = MFMA32(A, B0, a0); a1 = MFMA32(A, B1, a1); }
    bf16_t* out = SL + (size_t)(bh * 64 + c) * 16384;
#pragma unroll
    for (int r = 0; r < 16; ++r) { const int e = eb * 32 + crow(r, hi); out[e * 128 + dbp * 32 + r32] = cvt1(a0[r]); out[e * 128 + (dbp + 1) * 32 + r32] = cvt1(a1[r]); }
    __syncthreads();
}
__device__ __forceinline__ void b2_scan(int vcu, int G, bf16_t* SL, const float* DCH) {
    const int tid = threadIdx.x;
    for (int w = vcu; w < 256; w += G) { const int bh = w >> 4, part = w & 15; const int base = (part * 512 + tid) * 2, d = base & 127;
        float s0 = 0.f, s1 = 0.f;
        bf16_t* p = SL + (size_t)bh * 64 * 16384 + base; const float* dp = DCH + (size_t)bh * 64 * 128 + d;
        for (int c0 = 0; c0 < 64; c0 += 16) { unsigned sv[16]; f32x2_t dd[16];
#pragma unroll
            for (int j = 0; j < 16; ++j) { sv[j] = *(const unsigned*)(p + (size_t)(c0 + j) * 16384); dd[j] = *(const f32x2_t*)(dp + (c0 + j) * 128); }
#pragma unroll
            for (int j = 0; j < 16; ++j) { *(unsigned*)(p + (size_t)(c0 + j) * 16384) = cvtpk(s0, s1);
                s0 = dd[j].x * s0 + __uint_as_float(sv[j] << 16); s1 = dd[j].y * s1 + __uint_as_float(sv[j] & 0xffff0000u); } }
    }
}
__device__ __forceinline__ void b3_item(int bh, int c, const float* LF, const bf16_t* QS, const bf16_t* I, const bf16_t* SG, const bf16_t* ST, const float* hgn, bf16_t* OHG, LAS unsigned char* lds) {
    const int tid = threadIdx.x, lane = tid & 63, r32 = lane & 31, hi = lane >> 5; const int wid = __builtin_amdgcn_readfirstlane(tid >> 6);
    const int b = bh >> 2, h = bh & 3; const long rowc = (long)b * SEQ + c * 64;
    const int d = tid & 127, sc = tid >> 7; const int tm = wid >> 2, en = wid & 3;
    bf16x8 sf[8]; { const bf16_t* sp = ST + (size_t)(bh * 64 + c) * 16384 + (en * 32 + r32) * 128 + hi * 8;
#pragma unroll
        for (int ks = 0; ks < 8; ++ks) sf[ks] = *(const bf16x8*)(sp + ks * 16); }
    u32x4 vv[2];
#pragma unroll
    for (int i = 0; i < 2; ++i) { const int idx = tid + 512 * i, s = idx >> 4, ch = idx & 15; vv[i] = *(const u32x4*)(I + (rowc + s) * HGW + h * 128 + ch * 8); }
    float lf[16]; float qv[16]; { const float* lp = LF + (rowc + 16 * sc) * HGW + h * 128 + d; const bf16_t* qp = QS + (rowc + 16 * sc) * HGW + h * 128 + d;
#pragma unroll
        for (int i = 0; i < 16; ++i) { lf[i] = lp[(long)i * HGW]; qv[i] = bf2f(qp[(long)i * HGW]); } }
    float bc[16]; float run = 0.f;
#pragma unroll
    for (int i = 0; i < 16; ++i) { run += lf[i]; bc[i] = run; }
    LAS float* TOT = (LAS float*)lds; TOT[sc * 128 + d] = run;
    LAS unsigned char* QT = lds + 2048; LAS unsigned char* QA = lds + 19456; LAS unsigned char* K1 = lds + 36864; LAS unsigned char* K0 = lds + 54272; LAS unsigned char* VIMG = lds + 62976;
#pragma unroll
    for (int i = 0; i < 2; ++i) { const int idx = tid + 512 * i, s = idx >> 4, e0 = (idx & 15) * 8; *(LAS u32x4*)(VIMG + (e0 >> 5) * 4096 + (s >> 4) * 1024 + (s & 15) * 64 + (e0 & 31) * 2) = vv[i]; }
    __syncthreads();
    { const float t0 = TOT[d], t1 = TOT[128 + d], t2 = TOT[256 + d];
      const float pre = (sc > 0 ? t0 : 0.f) + (sc > 1 ? t1 : 0.f) + (sc > 2 ? t2 : 0.f); const float ref1 = t0 + t1; const float ref = (sc >= 2) ? ref1 : 0.f;
#pragma unroll
      for (int i = 0; i < 16; ++i) { const int s = 16 * sc + i; const float bcum = bc[i] + pre; const float k = 1.0f - fexp(lf[i]); const int off = s * IMG + d * 2;
          *(LAS bf16_t*)(QA + off) = cvt1(qv[i] * fexp(bcum));
          *(LAS bf16_t*)(QT + off) = cvt1(qv[i] * fexp(bcum - ref));
          *(LAS bf16_t*)(K1 + off) = cvt1(k * fexp(fminf(ref1 - bcum, 80.f)));
          if (sc < 2) *(LAS bf16_t*)(K0 + off) = cvt1(k * fexp(fminf(-bcum, 80.f))); } }
    __syncthreads();
    f32x16 o = {};
    { const LAS unsigned char* ap = QA + (32 * tm + r32) * IMG + hi * 16;
#pragma unroll
      for (int ks = 0; ks < 8; ++ks) o = MFMA32(*(const LAS bf16x8*)(ap + ks * 32), sf[ks], o); }
    const int laneoff = ((lane >> 4) & 1) * 32 + (lane & 3) * 8 + (4 * hi + ((lane & 15) >> 2)) * 64;
    const LAS unsigned char* kimg = tm ? K1 : K0;
    const LAS unsigned char* qp2 = QT + (32 * tm + r32) * IMG + hi * 16;
    for (int sh = 0; sh <= tm; ++sh) {
        f32x16 s_ = {};
        const LAS unsigned char* kp = kimg + (32 * sh + r32) * IMG + hi * 16;
#pragma unroll
        for (int ks = 0; ks < 8; ++ks) s_ = MFMA32(*(const LAS bf16x8*)(kp + ks * 32), *(const LAS bf16x8*)(qp2 + ks * 32), s_);
        if (sh == tm) {
#pragma unroll
            for (int r = 0; r < 16; ++r) if (crow(r, hi) > r32) s_[r] = 0.f; }
        const bf16x8 pa = pack8(s_, 0), pb = pack8(s_, 1);
        const bf16x8 vf0 = trfrag(VIMG + en * 4096 + (2 * sh) * 1024 + laneoff), vf1 = trfrag(VIMG + en * 4096 + (2 * sh + 1) * 1024 + laneoff);
        o = MFMA32(pa, vf0, o); o = MFMA32(pb, vf1, o);
    }
    __syncthreads();
    LAS float* OS = (LAS float*)(lds + 2048);
#pragma unroll
    for (int r = 0; r < 16; ++r) OS[(32 * tm + crow(r, hi)) * 132 + en * 32 + r32] = o[r];
    __syncthreads();
    { const int t = tid >> 3, j = tid & 7; float v[16]; float ss = 0.f;
#pragma unroll
      for (int q = 0; q < 4; ++q) { const f32x4 x = *(const LAS f32x4*)(OS + t * 132 + j * 16 + q * 4); v[4 * q] = x.x; v[4 * q + 1] = x.y; v[4 * q + 2] = x.z; v[4 * q + 3] = x.w; ss += (x.x * x.x + x.y * x.y) + (x.z * x.z + x.w * x.w); }
      ss += __shfl_xor(ss, 1); ss += __shfl_xor(ss, 2); ss += __shfl_xor(ss, 4);
      const float rs = __builtin_amdgcn_rsqf(ss * (1.0f / 128.0f) + EPS);
      const size_t go = (size_t)(rowc + t) * HGW + h * 128 + j * 16; const float* gp = hgn + h * 128 + j * 16;
      const u32x4 g0 = *(const u32x4*)(SG + go), g1 = *(const u32x4*)(SG + go + 8);
      const unsigned gw[8] = {g0.x, g0.y, g0.z, g0.w, g1.x, g1.y, g1.z, g1.w}; unsigned ow[8];
#pragma unroll
      for (int q = 0; q < 8; ++q) { const float y0 = v[2 * q] * rs * gp[2 * q] * __uint_as_float(gw[q] << 16), y1 = v[2 * q + 1] * rs * gp[2 * q + 1] * __uint_as_float(gw[q] & 0xffff0000u); ow[q] = cvtpk(y0, y1); }
      bf16_t* op = OHG + (size_t)(rowc + t) * 1024 + 512 + h * 128 + j * 16;
      *(u32x4*)op = (u32x4){ow[0], ow[1], ow[2], ow[3]}; *(u32x4*)(op + 8) = (u32x4){ow[4], ow[5], ow[6], ow[7]}; }
    __syncthreads();
}
}


#define XB_TMO      128
#define XB_XCNT(j)  (256  + 64 * (j))
#define XB_XSUB(j)  (1280 + 64 * (j))
#define XB_XGEN(j)  (2304 + 64 * (j))
#define XB_TOP      3328
#define XB_TOPGEN   3392
#define XCD_BAR_WORDS 3456
#define XB_SPIN_CAP (1u << 18)

__device__ __forceinline__ unsigned xb_ld(unsigned* p)              { return __hip_atomic_load(p, __ATOMIC_RELAXED, __HIP_MEMORY_SCOPE_AGENT); }
__device__ __forceinline__ unsigned xb_add(unsigned* p, unsigned v) { return __hip_atomic_fetch_add(p, v, __ATOMIC_RELAXED, __HIP_MEMORY_SCOPE_AGENT); }
__device__ __forceinline__ unsigned xb_xcc_id() { return (unsigned)__builtin_amdgcn_s_getreg((3 << 11) | 20) & 0xFu; }
#define XB_SPIN(cond, bar) do { unsigned _sp = 0; while (cond) { __builtin_amdgcn_s_sleep(1); \
    if ((++_sp & 255u) == 0u) { if (xb_ld(&(bar)[XB_TMO])) break; if (_sp > XB_SPIN_CAP) { atomicAdd(&(bar)[XB_TMO], 1u); break; } } } } while (0)

struct XcdBarrier {
    unsigned* bar; unsigned x;
    volatile LAS unsigned* st;
};

__device__ __forceinline__ XcdBarrier xcd_barrier_post(unsigned* bar, volatile LAS unsigned* st) {
    XcdBarrier b; b.bar = bar; b.x = xb_xcc_id(); b.st = st;
    if (threadIdx.x == 0) (void)xb_add(&bar[XB_XCNT(b.x)], 1u);
    return b;
}
__device__ __forceinline__ void xcd_barrier_complete(unsigned* bar, unsigned x, unsigned& nloc, unsigned& nx) {
    const unsigned G = gridDim.x * gridDim.y * gridDim.z;
    unsigned sum, cnt, mine, sp = 0u;
    for (;;) {
        sum = 0u; cnt = 0u; mine = 0u;
#pragma unroll
        for (unsigned j = 0; j < 16; ++j) { const unsigned c = xb_ld(&bar[XB_XCNT(j)]); sum += c; cnt += (c > 0u) ? 1u : 0u; mine = (j == x) ? c : mine; }
        if (sum == G) break;
        __builtin_amdgcn_s_sleep(1);
        if ((++sp & 255u) == 0u) { if (xb_ld(&bar[XB_TMO])) break; if (sp > XB_SPIN_CAP) { atomicAdd(&bar[XB_TMO], 1u); break; } }
    }
    nloc = mine > 0u ? mine : 1u; nx = cnt > 0u ? cnt : 1u;
}

__device__ __forceinline__ void xcd_barrier(const XcdBarrier& b) {
    asm volatile("s_waitcnt vmcnt(0)" ::: "memory");
    __syncthreads();
    if (threadIdx.x == 0) {
        unsigned* bar = b.bar;
        __builtin_amdgcn_s_waitcnt(0);
        unsigned nloc = b.st[0], nx = b.st[1];
        if (nloc == 0u) { xcd_barrier_complete(bar, b.x, nloc, nx); b.st[0] = nloc; b.st[1] = nx; }
        const unsigned old = xb_add(&bar[XB_XSUB(b.x)], 1u);
        const unsigned gen = old / nloc;
        if (old + 1u == (gen + 1u) * nloc) {
            __builtin_amdgcn_fence(__ATOMIC_RELEASE, "agent");
            asm volatile("s_waitcnt vmcnt(0)" ::: "memory");
            const unsigned og = xb_add(&bar[XB_TOP], 1u);
            const unsigned tg = og / nx;
            if (og + 1u == (tg + 1u) * nx) xb_add(&bar[XB_TOPGEN], 1u);
            else XB_SPIN(xb_ld(&bar[XB_TOPGEN]) == tg, bar);
            __builtin_amdgcn_fence(__ATOMIC_ACQUIRE, "agent");
            xb_add(&bar[XB_XGEN(b.x)], 1u);
            asm volatile("s_waitcnt vmcnt(0)" ::: "memory");
        } else {
            XB_SPIN(xb_ld(&bar[XB_XGEN(b.x)]) == gen, bar);
            __builtin_amdgcn_fence(__ATOMIC_ACQUIRE, "agent");
            asm volatile("s_waitcnt vmcnt(0)" ::: "memory");
        }
    }
    __syncthreads();
}

constexpr int NWAVES = 8;
#ifndef PROBE_MODE
#define PROBE_MODE 0
#endif
#ifndef MK_PER_PHASE
#define MK_PER_PHASE 0
#endif
constexpr int N_PHASES = 10;
constexpr size_t MiB = 1u << 20;
constexpr size_t WS_SS1 = 0, WS_SS2 = 65536, WS_BAR = 131072, WS_BAR_BYTES = 16384, WS_DCH = 262144;
constexpr size_t WS_WIN = 1 * MiB, WS_WOSB = 12 * MiB, WS_WOHG = 13 * MiB, WS_WOUT = 14 * MiB, WS_WFF1 = 16 * MiB, WS_WFF2 = 24 * MiB;
constexpr size_t WS_XN = 32 * MiB;
constexpr size_t WS_Q = 64 * MiB, WS_K = 80 * MiB, WS_V = 96 * MiB;
constexpr size_t WS_LF = 112 * MiB;
constexpr size_t WS_I = 144 * MiB, WS_QS = 160 * MiB, WS_SG = 176 * MiB, WS_OHG = 192 * MiB;
constexpr size_t WS_HB = 208 * MiB;
constexpr size_t WS_TMP = 112 * MiB;
constexpr size_t WS_AB = 64 * MiB;
constexpr size_t WS_END = 240 * MiB;
constexpr int RING_BYTES = 131072, LDS_BYTES = 147456;

__device__ __forceinline__ float wave_sum(float v) {
#pragma unroll
    for (int o = 1; o < 64; o <<= 1) v += __shfl_xor(v, o);
    return v;
}
__device__ __forceinline__ void p0_transpose_item(const float* W, int K, int N, bf16_t* WT, int pitch, const float* kscale, LAS float* scr, int item, int lane) {
    const int nblk = N / 32, kb = item / nblk, nb = item % nblk, k0 = 64 * kb, n0 = 32 * nb;
#pragma unroll 8
    for (int i = 0; i < 32; ++i) { const int kk = 2 * i + (lane >> 5); float w = W[(size_t)(k0 + kk) * N + n0 + (lane & 31)]; if (kscale) w *= kscale[k0 + kk]; scr[kk * 33 + (lane & 31)] = w; }
    asm volatile("s_waitcnt lgkmcnt(0)" ::: "memory");
    const int c = lane & 7;
#pragma unroll
    for (int j = 0; j < 4; ++j) { const int n = (lane >> 3) + 8 * j; const LAS float* s = scr + (8 * c) * 33 + n;
        u32x4 o; o.x = cvtpk(s[0 * 33], s[1 * 33]); o.y = cvtpk(s[2 * 33], s[3 * 33]); o.z = cvtpk(s[4 * 33], s[5 * 33]); o.w = cvtpk(s[6 * 33], s[7 * 33]);
        *(u32x4*)(WT + (size_t)(n0 + n) * pitch + k0 + 8 * c) = o; }
    asm volatile("s_waitcnt lgkmcnt(0)" ::: "memory");
}

struct Args { const float* in[13]; float* out; unsigned char* ws; int ph_lo, ph_hi; };
__global__ void __launch_bounds__(NWAVES * 64, 2) fwd_kernel(Args args) {
    extern __shared__ __attribute__((aligned(16))) unsigned char lds_raw[];
    LAS unsigned char* lds = (LAS unsigned char*)lds_raw;
    const int tid = threadIdx.x, lane = tid & 63, wave = __builtin_amdgcn_readfirstlane(tid >> 6);
    const int G = gridDim.x; const int bx = blockIdx.x; const int vcu = (G % 8 == 0) ? (bx % 8) * (G / 8) + bx / 8 : bx;
    unsigned char* ws = args.ws;
    const float* x = args.in[0]; const float* norm1_g = args.in[1]; const float* w_in = args.in[2]; const float* b_gate = args.in[3]; const float* lb_logits = args.in[4];
    const float* hg_norm_g = args.in[5]; const float* w_o_sb = args.in[6]; const float* w_o_hg = args.in[7]; const float* w_out = args.in[8]; const float* norm2_g = args.in[9];
    const float* w_ff1 = args.in[10]; const float* w_ff2 = args.in[11]; const float* final_g = args.in[12];
    float* out = args.out;
    float* SS1 = (float*)(ws + WS_SS1); float* SS2 = (float*)(ws + WS_SS2); float* DCH = (float*)(ws + WS_DCH);
    bf16_t* WIN = (bf16_t*)(ws + WS_WIN); bf16_t* WOSB = (bf16_t*)(ws + WS_WOSB); bf16_t* WOHG = (bf16_t*)(ws + WS_WOHG); bf16_t* WOUT = (bf16_t*)(ws + WS_WOUT);
    bf16_t* WFF1 = (bf16_t*)(ws + WS_WFF1); bf16_t* WFF2 = (bf16_t*)(ws + WS_WFF2);
    bf16_t* XN = (bf16_t*)(ws + WS_XN); bf16_t* SL = XN; bf16_t* MG = XN; bf16_t* H2B = XN;
    bf16_t* QB = (bf16_t*)(ws + WS_Q); bf16_t* KB = (bf16_t*)(ws + WS_K); bf16_t* VB = (bf16_t*)(ws + WS_V); float* LF = (float*)(ws + WS_LF);
    bf16_t* IB = (bf16_t*)(ws + WS_I); bf16_t* QS = (bf16_t*)(ws + WS_QS); bf16_t* SG = (bf16_t*)(ws + WS_SG); bf16_t* OHG = (bf16_t*)(ws + WS_OHG);
    bf16_t* HB = (bf16_t*)(ws + WS_HB); bf16_t* O2 = HB;   float* TMP = (float*)(ws + WS_TMP); bf16_t* AB = (bf16_t*)(ws + WS_AB);
    bf16_t* GA = (bf16_t*)out; bf16_t* GB = GA + (size_t)M * 1024;
    const int lo = args.ph_lo, hi = args.ph_hi;
    volatile LAS unsigned* bst = (volatile LAS unsigned*)(lds + RING_BYTES + 64);
    if (tid < 2) bst[tid] = 0u;
    __syncthreads();
    XcdBarrier bar = xcd_barrier_post((unsigned*)(ws + WS_BAR), bst);
    if (lo < 0) cg::this_grid().sync();
#define IN(k) (lo <= (k) && (k) < hi)
#define SEAM(k) do { if (IN(k) && IN((k) + 1)) { xcd_barrier(bar); if (PROBE_MODE == 3) xcd_barrier(bar); } } while (0)

    if (IN(0)) _Pragma("nounroll") for (int rep = 0; rep < (PROBE_MODE == 7 ? 2 : 1); ++rep) {
        LAS float* scr = (LAS float*)(lds + wave * 16384);
        const int gw = vcu * NWAVES + wave, NGW = G * NWAVES;
        constexpr int I_IN = (DM / 64) * (NIN / 32), I_OS = (512 / 64) * (DM / 32), I_OUT = (DM / 64) * (DM / 32), I_F1 = (DM / 64) * (FF / 32), I_F2 = (FF / 64) * (DM / 32);
        constexpr int NITEMS = I_IN + 2 * I_OS + I_OUT + I_F1 + I_F2;
        for (int it = gw; it < NITEMS; it += NGW) { int r = it;
            if (r < I_IN) { p0_transpose_item(w_in, DM, NIN, WIN, DM, nullptr, scr, r, lane); continue; } r -= I_IN;
            if (r < I_OS) { p0_transpose_item(w_o_sb, 512, DM, WOSB, 1024, nullptr, scr, r, lane); continue; } r -= I_OS;
            if (r < I_OS) { p0_transpose_item(w_o_hg, 512, DM, WOSB + 512, 1024, nullptr, scr, r, lane); continue; } r -= I_OS;
            if (r < I_OUT) { p0_transpose_item(w_out, DM, DM, WOUT, DM, nullptr, scr, r, lane); continue; } r -= I_OUT;
            if (r < I_F1) { p0_transpose_item(w_ff1, DM, FF, WFF1, DM, norm2_g, scr, r, lane); continue; } r -= I_F1;
            p0_transpose_item(w_ff2, FF, DM, WFF2, FF, nullptr, scr, r, lane); }
        for (int m = gw; m < M; m += NGW) { const f32x4* xr = (const f32x4*)(x + (size_t)m * DM) + lane; f32x4 v[4]; float s = 0.f;
#pragma unroll
            for (int j = 0; j < 4; ++j) { v[j] = xr[64 * j]; s += (v[j].x * v[j].x + v[j].y * v[j].y) + (v[j].z * v[j].z + v[j].w * v[j].w); }
            const float rs = __builtin_amdgcn_rsqf(wave_sum(s) * (1.0f / DM) + EPS);
            u32x2* o8 = (u32x2*)(XN + (size_t)m * DM) + lane;
#pragma unroll
            for (int j = 0; j < 4; ++j) { const f32x4 g = ((const f32x4*)norm1_g)[lane + 64 * j]; u32x2 w; w.x = cvtpk(v[j].x * rs * g.x, v[j].y * rs * g.y); w.y = cvtpk(v[j].z * rs * g.z, v[j].w * rs * g.w); o8[64 * j] = w; } }
        for (int i = bx * 512 + tid; i < 2 * M; i += G * 512) { if (i < M) SS1[i] = 0.f; else SS2[i - M] = 0.f; }
    }
    SEAM(0);
    if (IN(1)) { pg8::Gemm g{XN, WIN, M, NIN, DM}; pg8::StaticOrder S; S.init(M, NIN, G, bx);
        pg8::EpiIn E{QB, KB, VB, IB, QS, SG, GA, GB, LF, lb_logits, b_gate};
        _Pragma("nounroll") for (int rep = 0; rep < (PROBE_MODE == 4 ? 2 : 1); ++rep) pg8::gemm_phase<pg8::EpiIn, pg8::StaticOrder, true, true>(lds, g, S, E); }
    SEAM(1);
    if (IN(2)) { for (int rep = 0; rep < (PROBE_MODE == 2 ? 2 : 1); ++rep) for (int it = vcu; it < 1024; it += G) hg::b1_item(it >> 6, it & 63, LF, IB, SL, DCH, lds); }
    SEAM(2);
    if (IN(3)) { hg::b2_scan(vcu, G, SL, DCH); if (PROBE_MODE == 1) sb::phase<0>(vcu, G, QB, KB, VB, OHG, 512, lds); if (PROBE_MODE == 8) sb::phase<1>(vcu, G, QB, KB, VB, OHG, 512, lds); sb::phase<0>(vcu, G, QB, KB, VB, O2, 1024, lds); }
    SEAM(3);
    if (IN(4)) { for (int rep = 0; rep < (PROBE_MODE == 2 ? 2 : 1); ++rep) for (int it = vcu; it < 1024; it += G) hg::b3_item(it >> 6, it & 63, LF, QS, IB, SG, SL, hg_norm_g, O2, lds); }
    SEAM(4);
    if (IN(5)) { pg8::Gemm g{O2, WOSB, M, DM, DM}; pg8::StaticOrder S; S.init(M, DM, G, bx); pg8::EpiMerge E{GA, GB, MG};
        pg8::gemm_phase<pg8::EpiMerge, pg8::StaticOrder, true, true, 8>(lds, g, S, E); }
    SEAM(5);
    if (IN(6)) { pg8::Gemm g{MG, WOUT, M, DM, DM}; pg8::StaticOrder S; S.init(M, DM, G, bx); pg8::EpiResB E{x, nullptr, HB, SS1}; pg8::gemm_phase<pg8::EpiResB, pg8::StaticOrder, true, true>(lds, g, S, E); }
    SEAM(6);
    if (IN(7)) { pg8::Gemm g{HB, WFF1, M, FF, DM}; pg8::StaticOrder S; S.init(M, FF, G, bx); pg8::EpiFF1 E{SS1, AB}; _Pragma("nounroll") for (int rep = 0; rep < (PROBE_MODE == 6 ? 2 : 1); ++rep) pg8::gemm_phase<pg8::EpiFF1, pg8::StaticOrder, true, true>(lds, g, S, E); }
    SEAM(7);
    if (IN(8)) { pg8::Gemm g{AB, WFF2, M, DM, FF}; pg8::StaticOrder S; S.init(M, DM, G, bx); pg8::EpiResB E{nullptr, HB, H2B, SS2}; pg8::gemm_phase<pg8::EpiResB, pg8::StaticOrder, true, true>(lds, g, S, E); }
    SEAM(8);
    if (IN(9)) { const int gw = vcu * NWAVES + wave, NGW = G * NWAVES;
        for (int m = gw; m < M; m += NGW) { const u32x2* hr = (const u32x2*)(H2B + (size_t)m * DM) + lane; f32x4* xr = (f32x4*)(out + (size_t)m * DM) + lane; const float rs = __builtin_amdgcn_rsqf(SS2[m] * (1.0f / DM) + EPS);
#pragma unroll
            for (int j = 0; j < 4; ++j) { const f32x4 g = ((const f32x4*)final_g)[lane + 64 * j]; const u32x2 hv = hr[64 * j]; f32x4 v;
                v.x = __uint_as_float(hv.x << 16) * rs * g.x; v.y = __uint_as_float(hv.x & 0xffff0000u) * rs * g.y; v.z = __uint_as_float(hv.y << 16) * rs * g.z; v.w = __uint_as_float(hv.y & 0xffff0000u) * rs * g.w; xr[64 * j] = v; } } }
#undef IN
#undef SEAM
}

extern "C" void kernel_launch(void* const* d_in, const int* in_sizes, int n_in, void* d_out, int out_size, void* d_ws, size_t ws_size, hipStream_t stream) {
    static int grid = 0;
    if (grid == 0) {
        if (n_in != 13 || out_size != M * DM || ws_size < WS_END) { fprintf(stderr, "kernel_launch: unexpected problem (n_in %d out %d ws %zu)\n", n_in, out_size, ws_size); grid = -1; return; }
        int dev = 0, cus = 0, per_cu = 0;
        if (hipGetDevice(&dev) != hipSuccess || hipDeviceGetAttribute(&cus, hipDeviceAttributeMultiprocessorCount, dev) != hipSuccess) { grid = -1; return; }
        if (hipFuncSetAttribute((const void*)fwd_kernel, hipFuncAttributeMaxDynamicSharedMemorySize, LDS_BYTES) != hipSuccess) { fprintf(stderr, "kernel_launch: hipFuncSetAttribute failed\n"); grid = -1; return; }
        if (hipOccupancyMaxActiveBlocksPerMultiprocessor(&per_cu, (const void*)fwd_kernel, NWAVES * 64, LDS_BYTES) != hipSuccess || per_cu < 1) { fprintf(stderr, "kernel_launch: occupancy query says %d\n", per_cu); per_cu = 1; }
        (void)hipGetLastError();
        grid = cus;
    }
    if (grid < 0) return;
    if (hipMemsetAsync((char*)d_ws + WS_BAR, 0, WS_BAR_BYTES, stream) != hipSuccess) { fprintf(stderr, "kernel_launch: memset of the barrier words failed\n"); return; }
    Args a{};
    for (int i = 0; i < 13; ++i) a.in[i] = (const float*)d_in[i];
    a.out = (float*)d_out; a.ws = (unsigned char*)d_ws;
#if MK_PER_PHASE
    for (int p = 0; p < N_PHASES; ++p) { a.ph_lo = p; a.ph_hi = p + 1; hipLaunchKernelGGL(fwd_kernel, dim3(grid), dim3(NWAVES * 64), LDS_BYTES, stream, a); }
#else
    a.ph_lo = 0; a.ph_hi = N_PHASES;
    void* kargs[] = {&a};
    const hipError_t e = hipLaunchCooperativeKernel((const void*)fwd_kernel, dim3(grid), dim3(NWAVES * 64), kargs, LDS_BYTES, stream);
    if (e != hipSuccess) fprintf(stderr, "kernel_launch: cooperative launch failed: %s (grid %d)\n", hipGetErrorString(e), grid);
#endif
}
```
